# Optimizing an MI355X kernel written in HIP

```python
import math
import jax, jax.numpy as jnp
from jax import lax
import numpy as np

D_MODEL = 1024
BATCH = 8
SEQ = 4096
DEPTH = 1

CHUNK = 64
LEFT_CHUNKS = 8
BAND = LEFT_CHUNKS + 1
D_CONV = D_MODEL // 2
CONV_WIDTH = 31
N_HEADS = 8
HEAD_DIM = 64
D_ATTN = N_HEADS * HEAD_DIM
MAX_REL = 128
N_REL = 2 * MAX_REL + 1
LN_EPS = 1e-5
DEEPNORM_ALPHA = (2.0 * DEPTH) ** 0.25
DEEPNORM_BETA = (8.0 * DEPTH) ** -0.25

COL_SPLITS = [
    D_CONV,
    D_CONV,
    D_CONV,
    D_ATTN,
    D_ATTN,
    D_ATTN,
    D_ATTN,
    D_MODEL,
    D_MODEL,
]
D_IN = sum(COL_SPLITS)

kernel_name = "hybrid_conformer_conv_chunk_attn_deepnorm"


def _layer_norm(x, g, b):
    xf = x.astype(jnp.float32)
    mu = jnp.mean(xf, axis=-1, keepdims=True)
    var = jnp.mean(jnp.square(xf - mu), axis=-1, keepdims=True)
    y = (xf - mu) * lax.rsqrt(var + LN_EPS) * g.astype(jnp.float32) + b.astype(jnp.float32)
    return y.astype(x.dtype)


def _causal_depthwise_conv(u, w, b):
    c = u.shape[-1]
    y = lax.conv_general_dilated(
        u, w.reshape(CONV_WIDTH, 1, c).astype(u.dtype),
        window_strides=(1,), padding=((CONV_WIDTH - 1, 0),),
        dimension_numbers=("NWC", "WIO", "NWC"), feature_group_count=c)
    return y + b


def _chunked_attention(q, k, v, rel_bias):
    bsz, seq, _ = q.shape
    n_chunks = seq // CHUNK
    q = q.reshape(bsz, n_chunks, CHUNK, N_HEADS, HEAD_DIM)
    k = k.reshape(bsz, n_chunks, CHUNK, N_HEADS, HEAD_DIM)
    v = v.reshape(bsz, n_chunks, CHUNK, N_HEADS, HEAD_DIM)
    pad = ((0, 0), (LEFT_CHUNKS, 0), (0, 0), (0, 0), (0, 0))
    kp = jnp.pad(k, pad)
    vp = jnp.pad(v, pad)
    kb = jnp.concatenate([kp[:, w:w + n_chunks] for w in range(BAND)], axis=2)
    vb = jnp.concatenate([vp[:, w:w + n_chunks] for w in range(BAND)], axis=2)

    scale = 1.0 / math.sqrt(HEAD_DIM)
    s = jnp.einsum("bnqhd,bnkhd->bhnqk", q, kb).astype(jnp.float32) * scale

    qi = np.arange(CHUNK)[:, None]
    kj = np.arange(BAND * CHUNK)[None, :]
    rel = np.clip(LEFT_CHUNKS * CHUNK + qi - kj, -MAX_REL, MAX_REL) + MAX_REL
    bias = rel_bias.astype(jnp.float32)[:, rel]
    s = s + bias[:, None]

    key_chunk = np.arange(n_chunks)[:, None] - LEFT_CHUNKS + (np.arange(BAND * CHUNK) // CHUNK)[None, :]
    valid = jnp.asarray(key_chunk >= 0)
    s = jnp.where(valid[:, None, :], s, -1e30)
    p = jax.nn.softmax(s, axis=-1).astype(v.dtype)
    o = jnp.einsum("bhnqk,bnkhd->bnqhd", p, vb)
    return o.reshape(bsz, seq, D_ATTN)


def setup_inputs(seed: int = 0) -> dict:
    key = jax.random.key(seed)
    ks = jax.random.split(key, 16)
    f32 = jnp.float32
    x = jax.random.normal(ks[0], (BATCH, SEQ, D_MODEL), f32)

    w_in = jax.random.normal(ks[1], (D_MODEL, D_IN), f32) * D_MODEL ** -0.5
    v_start = 3 * D_CONV + 2 * D_ATTN
    col_scale = jnp.ones((D_IN,), f32).at[v_start:v_start + D_ATTN].set(DEEPNORM_BETA)
    w_in = w_in * col_scale
    b_in = jax.random.normal(ks[2], (D_IN,), f32) * 0.02

    conv_w = jax.random.normal(ks[3], (CONV_WIDTH, D_CONV), f32) * CONV_WIDTH ** -0.5
    conv_b = jax.random.normal(ks[4], (D_CONV,), f32) * 0.02
    conv_ln_g = 1.0 + 0.05 * jax.random.normal(ks[5], (D_CONV,), f32)
    conv_ln_b = 0.02 * jax.random.normal(ks[6], (D_CONV,), f32)
    w_conv_out = jax.random.normal(ks[7], (D_CONV, D_MODEL), f32) * D_CONV ** -0.5 * DEEPNORM_BETA

    rel_bias = 0.2 * jax.random.normal(ks[8], (N_HEADS, N_REL), f32)
    w_attn_out = jax.random.normal(ks[9], (D_ATTN, D_MODEL), f32) * D_ATTN ** -0.5 * DEEPNORM_BETA

    w_o = jax.random.normal(ks[10], (D_MODEL, D_MODEL), f32) * D_MODEL ** -0.5 * DEEPNORM_BETA
    b_o = 0.02 * jax.random.normal(ks[11], (D_MODEL,), f32)
    out_ln_g = 1.0 + 0.05 * jax.random.normal(ks[12], (D_MODEL,), f32)
    out_ln_b = 0.02 * jax.random.normal(ks[13], (D_MODEL,), f32)
    return {
        "x": x, "w_in": w_in, "b_in": b_in,
        "conv_w": conv_w, "conv_b": conv_b, "conv_ln_g": conv_ln_g, "conv_ln_b": conv_ln_b,
        "w_conv_out": w_conv_out, "rel_bias": rel_bias, "w_attn_out": w_attn_out,
        "w_o": w_o, "b_o": b_o, "out_ln_g": out_ln_g, "out_ln_b": out_ln_b,
    }


def reference(x, w_in, b_in, conv_w, conv_b, conv_ln_g, conv_ln_b, w_conv_out,
              rel_bias, w_attn_out, w_o, b_o, out_ln_g, out_ln_b):
    offsets = np.cumsum(COL_SPLITS)[:-1].tolist()
    for _ in range(DEPTH):
        z = jnp.einsum("bsd,de->bse", x, w_in) + b_in
        (c_val, c_glu, c_gate, q, k, v, a_gate, g_conv, g_attn) = jnp.split(z, offsets, axis=-1)

        u = c_val * jax.nn.sigmoid(c_glu)
        u = _causal_depthwise_conv(u, conv_w, conv_b)
        u = jax.nn.silu(_layer_norm(u, conv_ln_g, conv_ln_b))
        conv_out = jnp.einsum("bsc,cd->bsd", u * jax.nn.silu(c_gate), w_conv_out)

        o = _chunked_attention(q, k, v, rel_bias)
        attn_out = jnp.einsum("bsc,cd->bsd", o * jax.nn.silu(a_gate), w_attn_out)

        h = jax.nn.sigmoid(g_conv) * conv_out + jax.nn.sigmoid(g_attn) * attn_out
        y = jnp.einsum("bsd,de->bse", h, w_o) + b_o

        x = _layer_norm(DEEPNORM_ALPHA * x + y, out_ln_g, out_ln_b)
    return x
```

```cpp
#include <hip/hip_runtime.h>
#include <cstdio>
#include <cstdint>

typedef unsigned short bf16_t;
typedef short bf16x8 __attribute__((ext_vector_type(8)));
typedef float f32x4 __attribute__((ext_vector_type(4)));
typedef unsigned u32x4 __attribute__((ext_vector_type(4)));

constexpr int BATCH = 8, SEQ = 4096, DM = 1024, M = BATCH * SEQ;
constexpr int DC = 512, DA = 512, NH = 8, HD = 64, CW = 31, DIN = 5632, CHUNK = 64, NCH = SEQ / CHUNK, LEFT = 8;
constexpr int MAX_REL = 128, N_REL = 257;
constexpr int O_CVAL = 0, O_CGLU = 512, O_CGATE = 1024, O_Q = 1536, O_K = 2048, O_V = 2560, O_AG = 3072, O_GC = 3584, O_GA = 4608;
constexpr float LN_EPS = 1e-5f;
constexpr float ALPHA = 1.189207115002721f;

constexpr size_t MiB = 1u << 20;
constexpr size_t WS_WIN = 2 * MiB, WS_WC = 14 * MiB, WS_WA = 15 * MiB, WS_WO = 16 * MiB;
constexpr size_t WS_XB = 32 * MiB;
constexpr size_t WS_H = 32 * MiB;
constexpr size_t WS_Z = 96 * MiB;
constexpr size_t WS_UC = 448 * MiB;
constexpr size_t WS_OG = 480 * MiB;
constexpr size_t WS_END = 512 * MiB;

__device__ __forceinline__ unsigned f2bf(float f) { unsigned u = __builtin_bit_cast(unsigned, f); return (u + 0x7fffu + ((u >> 16) & 1u)) >> 16; }
__device__ __forceinline__ unsigned pk2(float lo, float hi) { return f2bf(lo) | (f2bf(hi) << 16); }
__device__ __forceinline__ float bf2f(bf16_t b) { return __uint_as_float(((unsigned)b) << 16); }
__device__ __forceinline__ float bflo(unsigned w) { return __uint_as_float(w << 16); }
__device__ __forceinline__ float bfhi(unsigned w) { return __uint_as_float(w & 0xffff0000u); }
__device__ __forceinline__ float sigmoidf_(float x) { return 1.0f / (1.0f + __expf(-x)); }
__device__ __forceinline__ float siluf_(float x) { return x / (1.0f + __expf(-x)); }

__global__ void __launch_bounds__(256) k_cvt(const float* __restrict__ x, bf16_t* __restrict__ xb, size_t n8) {
    for (size_t i = (size_t)blockIdx.x * blockDim.x + threadIdx.x; i < n8; i += (size_t)gridDim.x * blockDim.x) {
        const f32x4 a = ((const f32x4*)x)[2 * i], b = ((const f32x4*)x)[2 * i + 1];
        u32x4 o; o.x = pk2(a.x, a.y); o.y = pk2(a.z, a.w); o.z = pk2(b.x, b.y); o.w = pk2(b.z, b.w);
        ((u32x4*)xb)[i] = o;
    }
}
__global__ void __launch_bounds__(256) k_transpose(const float* __restrict__ W, bf16_t* __restrict__ Wt, int K, int N) {
    const size_t total = (size_t)K * N;
    for (size_t i = (size_t)blockIdx.x * blockDim.x + threadIdx.x; i < total; i += (size_t)gridDim.x * blockDim.x) {
        const int n = (int)(i / K), k = (int)(i % K);
        Wt[i] = (bf16_t)f2bf(W[(size_t)k * N + n]);
    }
}

struct EpiArgs { bf16_t* z; const float* bias; float* f32buf; bf16_t* h; const float* x; };
template <int EPI> __device__ __forceinline__ void epi_store(const EpiArgs& e, int r, int c, float v) {
    if (EPI == 0) { e.z[(size_t)r * DIN + c] = (bf16_t)f2bf(v + e.bias[c]); }
    else if (EPI == 1) { const float g = bf2f(e.z[(size_t)r * DIN + O_GC + c]); e.f32buf[(size_t)r * DM + c] = sigmoidf_(g) * v; }
    else if (EPI == 2) { const float g = bf2f(e.z[(size_t)r * DIN + O_GA + c]); e.h[(size_t)r * DM + c] = (bf16_t)f2bf(e.f32buf[(size_t)r * DM + c] + sigmoidf_(g) * v); }
    else { e.f32buf[(size_t)r * DM + c] = ALPHA * e.x[(size_t)r * DM + c] + v + e.bias[c]; }
}
template <int EPI> __global__ void __launch_bounds__(256) k_gemm(const bf16_t* __restrict__ A, int lda, const bf16_t* __restrict__ Bt, int ldb, int K, EpiArgs e) {
    const int tid = threadIdx.x, wid = tid >> 6, lane = tid & 63, wr = wid >> 1, wc = wid & 1, fr = lane & 15, fq = lane >> 4;
    const int row0 = blockIdx.y * 128 + wr * 64, col0 = blockIdx.x * 128 + wc * 64;
    f32x4 acc[4][4];
#pragma unroll
    for (int m = 0; m < 4; ++m)
#pragma unroll
        for (int n = 0; n < 4; ++n) acc[m][n] = (f32x4){0.f, 0.f, 0.f, 0.f};
    const bf16_t* ap = A + (size_t)(row0 + fr) * lda + fq * 8;
    const bf16_t* bp = Bt + (size_t)(col0 + fr) * ldb + fq * 8;
    for (int k0 = 0; k0 < K; k0 += 32) {
        bf16x8 a[4], b[4];
#pragma unroll
        for (int m = 0; m < 4; ++m) a[m] = *(const bf16x8*)(ap + (size_t)(m * 16) * lda + k0);
#pragma unroll
        for (int n = 0; n < 4; ++n) b[n] = *(const bf16x8*)(bp + (size_t)(n * 16) * ldb + k0);
#pragma unroll
        for (int m = 0; m < 4; ++m)
#pragma unroll
            for (int n = 0; n < 4; ++n) acc[m][n] = __builtin_amdgcn_mfma_f32_16x16x32_bf16(a[m], b[n], acc[m][n], 0, 0, 0);
    }
#pragma unroll
    for (int m = 0; m < 4; ++m)
#pragma unroll
        for (int n = 0; n < 4; ++n)
#pragma unroll
            for (int j = 0; j < 4; ++j) epi_store<EPI>(e, row0 + m * 16 + fq * 4 + j, col0 + n * 16 + fr, acc[m][n][j]);
}

constexpr int CT = 8;
__global__ void __launch_bounds__(512) k_conv(const bf16_t* __restrict__ z, const float* __restrict__ cw, const float* __restrict__ cb,
                                              const float* __restrict__ lng, const float* __restrict__ lnb, bf16_t* __restrict__ uc) {
    __shared__ float sm[8][CT];
    const int c = threadIdx.x, wave = c >> 6, lane = c & 63;
    const int t0 = blockIdx.x * CT;
    const int s0 = t0 % SEQ;
    float w[CW];
#pragma unroll
    for (int j = 0; j < CW; ++j) w[j] = cw[j * DC + c];
    float acc[CT];
    const float bias = cb[c];
#pragma unroll
    for (int i = 0; i < CT; ++i) acc[i] = bias;
#pragma unroll
    for (int p = 0; p < CT + CW - 1; ++p) {
        const int sp = s0 - (CW - 1) + p;
        float g = 0.f;
        if (sp >= 0) { const size_t r = (size_t)(t0 - (CW - 1) + p); const float a = bf2f(z[r * DIN + O_CVAL + c]), b = bf2f(z[r * DIN + O_CGLU + c]); g = a * sigmoidf_(b); }
#pragma unroll
        for (int i = 0; i < CT; ++i) { const int j = p - i; if (j >= 0 && j < CW) acc[i] += w[j] * g; }
    }
    float red[CT];
#pragma unroll
    for (int i = 0; i < CT; ++i) { float v = acc[i];
#pragma unroll
        for (int o = 1; o < 64; o <<= 1) v += __shfl_xor(v, o);
        red[i] = v; }
    if (lane == 0) {
#pragma unroll
        for (int i = 0; i < CT; ++i) sm[wave][i] = red[i]; }
    __syncthreads();
    float mean[CT];
#pragma unroll
    for (int i = 0; i < CT; ++i) { float s = 0.f;
#pragma unroll
        for (int wv = 0; wv < 8; ++wv) s += sm[wv][i];
        mean[i] = s * (1.0f / DC); }
    __syncthreads();
#pragma unroll
    for (int i = 0; i < CT; ++i) { const float d = acc[i] - mean[i]; float v = d * d;
#pragma unroll
        for (int o = 1; o < 64; o <<= 1) v += __shfl_xor(v, o);
        red[i] = v; }
    if (lane == 0) {
#pragma unroll
        for (int i = 0; i < CT; ++i) sm[wave][i] = red[i]; }
    __syncthreads();
    const float g_ = lng[c], b_ = lnb[c];
#pragma unroll
    for (int i = 0; i < CT; ++i) { float s = 0.f;
#pragma unroll
        for (int wv = 0; wv < 8; ++wv) s += sm[wv][i];
        const float rstd = 1.0f / sqrtf(s * (1.0f / DC) + LN_EPS);
        const float y = (acc[i] - mean[i]) * rstd * g_ + b_;
        const float gate = bf2f(z[(size_t)(t0 + i) * DIN + O_CGATE + c]);
        uc[(size_t)(t0 + i) * DC + c] = (bf16_t)f2bf(siluf_(y) * siluf_(gate)); }
}

__global__ void __launch_bounds__(64) k_attn(const bf16_t* __restrict__ z, const float* __restrict__ relb, bf16_t* __restrict__ og) {
    const int u = blockIdx.x, h = u & 7, n = (u >> 3) & 63, b = u >> 9, i = threadIdx.x;
    const size_t qrow = (size_t)b * SEQ + (size_t)n * CHUNK + i;
    float q[HD], o[HD];
    { const u32x4* qp = (const u32x4*)(z + qrow * DIN + O_Q + h * HD);
#pragma unroll
      for (int d8 = 0; d8 < 8; ++d8) { const u32x4 v = qp[d8];
          q[d8 * 8 + 0] = bflo(v.x) * 0.125f; q[d8 * 8 + 1] = bfhi(v.x) * 0.125f; q[d8 * 8 + 2] = bflo(v.y) * 0.125f; q[d8 * 8 + 3] = bfhi(v.y) * 0.125f;
          q[d8 * 8 + 4] = bflo(v.z) * 0.125f; q[d8 * 8 + 5] = bfhi(v.z) * 0.125f; q[d8 * 8 + 6] = bflo(v.w) * 0.125f; q[d8 * 8 + 7] = bfhi(v.w) * 0.125f; } }
#pragma unroll
    for (int d = 0; d < HD; ++d) o[d] = 0.f;
    float mx = -1e30f, l = 0.f;
    const float* rb = relb + h * N_REL;
    const int w0 = (LEFT - n) > 0 ? (LEFT - n) : 0;
    for (int w = w0; w <= LEFT; ++w) {
        const int kc = n - LEFT + w;
        for (int jj = 0; jj < CHUNK; ++jj) {
            const size_t krow = (size_t)b * SEQ + (size_t)kc * CHUNK + jj;
            const u32x4* kp = (const u32x4*)(z + krow * DIN + O_K + h * HD);
            float s = 0.f;
#pragma unroll
            for (int d8 = 0; d8 < 8; ++d8) { const u32x4 v = kp[d8];
                s += q[d8 * 8 + 0] * bflo(v.x) + q[d8 * 8 + 1] * bfhi(v.x) + q[d8 * 8 + 2] * bflo(v.y) + q[d8 * 8 + 3] * bfhi(v.y)
                   + q[d8 * 8 + 4] * bflo(v.z) + q[d8 * 8 + 5] * bfhi(v.z) + q[d8 * 8 + 6] * bflo(v.w) + q[d8 * 8 + 7] * bfhi(v.w); }
            int rel = LEFT * CHUNK + i - (w * CHUNK + jj); rel = rel < -MAX_REL ? -MAX_REL : (rel > MAX_REL ? MAX_REL : rel);
            s += rb[rel + MAX_REL];
            if (s > mx) { const float a = __expf(mx - s); l *= a;
#pragma unroll
                for (int d = 0; d < HD; ++d) o[d] *= a;
                mx = s; }
            const float p = __expf(s - mx); l += p;
            const u32x4* vp = (const u32x4*)(z + krow * DIN + O_V + h * HD);
#pragma unroll
            for (int d8 = 0; d8 < 8; ++d8) { const u32x4 v = vp[d8];
                o[d8 * 8 + 0] += p * bflo(v.x); o[d8 * 8 + 1] += p * bfhi(v.x); o[d8 * 8 + 2] += p * bflo(v.y); o[d8 * 8 + 3] += p * bfhi(v.y);
                o[d8 * 8 + 4] += p * bflo(v.z); o[d8 * 8 + 5] += p * bfhi(v.z); o[d8 * 8 + 6] += p * bflo(v.w); o[d8 * 8 + 7] += p * bfhi(v.w); }
        }
    }
    const float il = 1.0f / l;
    const u32x4* gp = (const u32x4*)(z + qrow * DIN + O_AG + h * HD);
    u32x4* op = (u32x4*)(og + qrow * DA + h * HD);
#pragma unroll
    for (int d8 = 0; d8 < 8; ++d8) { const u32x4 g = gp[d8]; u32x4 r;
        r.x = pk2(o[d8 * 8 + 0] * il * siluf_(bflo(g.x)), o[d8 * 8 + 1] * il * siluf_(bfhi(g.x)));
        r.y = pk2(o[d8 * 8 + 2] * il * siluf_(bflo(g.y)), o[d8 * 8 + 3] * il * siluf_(bfhi(g.y)));
        r.z = pk2(o[d8 * 8 + 4] * il * siluf_(bflo(g.z)), o[d8 * 8 + 5] * il * siluf_(bfhi(g.z)));
        r.w = pk2(o[d8 * 8 + 6] * il * siluf_(bflo(g.w)), o[d8 * 8 + 7] * il * siluf_(bfhi(g.w)));
        op[d8] = r; }
}

__global__ void __launch_bounds__(256) k_ln(float* __restrict__ out, const float* __restrict__ g, const float* __restrict__ bta) {
    const int lane = threadIdx.x & 63, row = blockIdx.x * 4 + (threadIdx.x >> 6);
    f32x4* p = (f32x4*)(out + (size_t)row * DM) + lane;
    f32x4 v[4]; float s = 0.f;
#pragma unroll
    for (int j = 0; j < 4; ++j) { v[j] = p[64 * j]; s += (v[j].x + v[j].y) + (v[j].z + v[j].w); }
#pragma unroll
    for (int o = 1; o < 64; o <<= 1) s += __shfl_xor(s, o);
    const float mean = s * (1.0f / DM); float s2 = 0.f;
#pragma unroll
    for (int j = 0; j < 4; ++j) { v[j] = v[j] - mean; s2 += (v[j].x * v[j].x + v[j].y * v[j].y) + (v[j].z * v[j].z + v[j].w * v[j].w); }
#pragma unroll
    for (int o = 1; o < 64; o <<= 1) s2 += __shfl_xor(s2, o);
    const float rstd = 1.0f / sqrtf(s2 * (1.0f / DM) + LN_EPS);
#pragma unroll
    for (int j = 0; j < 4; ++j) { const f32x4 gg = ((const f32x4*)g)[lane + 64 * j], bb = ((const f32x4*)bta)[lane + 64 * j]; p[64 * j] = v[j] * rstd * gg + bb; }
}

extern "C" void kernel_launch(void* const* d_in, const int* in_sizes, int n_in, void* d_out, int out_size, void* d_ws, size_t ws_size, hipStream_t stream) {
    if (n_in != 14 || in_sizes[0] != M * DM || out_size != M * DM || ws_size < WS_END) { fprintf(stderr, "kernel_launch: unexpected shapes / workspace (n_in %d, ws %zu)\n", n_in, ws_size); return; }
    const float* x = (const float*)d_in[0]; const float* w_in = (const float*)d_in[1]; const float* b_in = (const float*)d_in[2];
    const float* conv_w = (const float*)d_in[3]; const float* conv_b = (const float*)d_in[4]; const float* cln_g = (const float*)d_in[5]; const float* cln_b = (const float*)d_in[6];
    const float* w_co = (const float*)d_in[7]; const float* relb = (const float*)d_in[8]; const float* w_ao = (const float*)d_in[9];
    const float* w_o = (const float*)d_in[10]; const float* b_o = (const float*)d_in[11]; const float* oln_g = (const float*)d_in[12]; const float* oln_b = (const float*)d_in[13];
    unsigned char* ws = (unsigned char*)d_ws; float* out = (float*)d_out;
    bf16_t* Win_t = (bf16_t*)(ws + WS_WIN); bf16_t* Wc_t = (bf16_t*)(ws + WS_WC); bf16_t* Wa_t = (bf16_t*)(ws + WS_WA); bf16_t* Wo_t = (bf16_t*)(ws + WS_WO);
    bf16_t* xb = (bf16_t*)(ws + WS_XB); bf16_t* hb = (bf16_t*)(ws + WS_H); bf16_t* z = (bf16_t*)(ws + WS_Z); bf16_t* uc = (bf16_t*)(ws + WS_UC); bf16_t* og = (bf16_t*)(ws + WS_OG);

    k_cvt<<<2048, 256, 0, stream>>>(x, xb, (size_t)M * DM / 8);
    k_transpose<<<2048, 256, 0, stream>>>(w_in, Win_t, DM, DIN);
    k_transpose<<<512, 256, 0, stream>>>(w_co, Wc_t, DC, DM);
    k_transpose<<<512, 256, 0, stream>>>(w_ao, Wa_t, DA, DM);
    k_transpose<<<1024, 256, 0, stream>>>(w_o, Wo_t, DM, DM);
    EpiArgs e{}; e.z = z; e.bias = b_in; e.f32buf = out; e.h = hb; e.x = x;
    k_gemm<0><<<dim3(DIN / 128, M / 128), 256, 0, stream>>>(xb, DM, Win_t, DM, DM, e);
    k_conv<<<M / CT, 512, 0, stream>>>(z, conv_w, conv_b, cln_g, cln_b, uc);
    k_attn<<<BATCH * NCH * NH, 64, 0, stream>>>(z, relb, og);
    k_gemm<1><<<dim3(DM / 128, M / 128), 256, 0, stream>>>(uc, DC, Wc_t, DC, DC, e);
    k_gemm<2><<<dim3(DM / 128, M / 128), 256, 0, stream>>>(og, DA, Wa_t, DA, DA, e);
    e.bias = b_o;
    k_gemm<3><<<dim3(DM / 128, M / 128), 256, 0, stream>>>(hb, DM, Wo_t, DM, DM, e);
    k_ln<<<M / 4, 256, 0, stream>>>(out, oln_g, oln_b);
}
```

```cpp
#include <hip/hip_runtime.h>
#include <hip/hip_cooperative_groups.h>
namespace cg = cooperative_groups;
#include <cstdio>
#include <cstdint>

typedef unsigned short bf16_t;
typedef short bf16x8 __attribute__((ext_vector_type(8)));
typedef float f32x4 __attribute__((ext_vector_type(4)));
typedef unsigned u32x4 __attribute__((ext_vector_type(4)));

constexpr int BATCH = 8, SEQ = 4096, DM = 1024, M = BATCH * SEQ;
constexpr int DC = 512, DA = 512, NH = 8, HD = 64, CW = 31, DIN = 5632, CHUNK = 64, NCH = SEQ / CHUNK, LEFT = 8;
constexpr int MAX_REL = 128, N_REL = 257;
constexpr int O_CVAL = 0, O_CGLU = 512, O_CGATE = 1024, O_Q = 1536, O_K = 2048, O_V = 2560, O_AG = 3072, O_GC = 3584, O_GA = 4608;
constexpr float LN_EPS = 1e-5f;
constexpr float ALPHA = 1.189207115002721f;

constexpr size_t MiB = 1u << 20;
constexpr size_t WS_WIN = 2 * MiB, WS_WC = 14 * MiB, WS_WA = 15 * MiB, WS_WO = 16 * MiB;
constexpr size_t WS_XB = 32 * MiB;
constexpr size_t WS_H = 32 * MiB;
constexpr size_t WS_Z = 96 * MiB;
constexpr size_t WS_UC = 448 * MiB;
constexpr size_t WS_OG = 480 * MiB;
constexpr size_t WS_END = 512 * MiB;

__device__ __forceinline__ unsigned f2bf(float f) { unsigned u = __builtin_bit_cast(unsigned, f); return (u + 0x7fffu + ((u >> 16) & 1u)) >> 16; }
__device__ __forceinline__ unsigned pk2(float lo, float hi) { return f2bf(lo) | (f2bf(hi) << 16); }
__device__ __forceinline__ float bf2f(bf16_t b) { return __uint_as_float(((unsigned)b) << 16); }
__device__ __forceinline__ float bflo(unsigned w) { return __uint_as_float(w << 16); }
__device__ __forceinline__ float bfhi(unsigned w) { return __uint_as_float(w & 0xffff0000u); }
__device__ __forceinline__ float sigmoidf_(float x) { return 1.0f / (1.0f + __expf(-x)); }
__device__ __forceinline__ float siluf_(float x) { return x / (1.0f + __expf(-x)); }

__device__ __forceinline__ void p_cvt(const float* __restrict__ x, bf16_t* __restrict__ xb, size_t n8) {
    for (size_t i = (size_t)blockIdx.x * blockDim.x + threadIdx.x; i < n8; i += (size_t)gridDim.x * blockDim.x) {
        const f32x4 a = ((const f32x4*)x)[2 * i], b = ((const f32x4*)x)[2 * i + 1];
        u32x4 o; o.x = pk2(a.x, a.y); o.y = pk2(a.z, a.w); o.z = pk2(b.x, b.y); o.w = pk2(b.z, b.w);
        ((u32x4*)xb)[i] = o;
    }
}
__device__ __forceinline__ void p_transpose(const float* __restrict__ W, bf16_t* __restrict__ Wt, int K, int N) {
    const size_t total = (size_t)K * N;
    for (size_t i = (size_t)blockIdx.x * blockDim.x + threadIdx.x; i < total; i += (size_t)gridDim.x * blockDim.x) {
        const int n = (int)(i / K), k = (int)(i % K);
        Wt[i] = (bf16_t)f2bf(W[(size_t)k * N + n]);
    }
}

struct EpiArgs { bf16_t* z; const float* bias; float* f32buf; bf16_t* h; const float* x; };
template <int EPI> __device__ __forceinline__ void epi_store(const EpiArgs& e, int r, int c, float v) {
    if (EPI == 0) { e.z[(size_t)r * DIN + c] = (bf16_t)f2bf(v + e.bias[c]); }
    else if (EPI == 1) { const float g = bf2f(e.z[(size_t)r * DIN + O_GC + c]); e.f32buf[(size_t)r * DM + c] = sigmoidf_(g) * v; }
    else if (EPI == 2) { const float g = bf2f(e.z[(size_t)r * DIN + O_GA + c]); e.h[(size_t)r * DM + c] = (bf16_t)f2bf(e.f32buf[(size_t)r * DM + c] + sigmoidf_(g) * v); }
    else { e.f32buf[(size_t)r * DM + c] = ALPHA * e.x[(size_t)r * DM + c] + v + e.bias[c]; }
}
template <int EPI> __device__ __forceinline__ void p_gemm(const bf16_t* __restrict__ A, int lda, const bf16_t* __restrict__ Bt, int ldb, int K, int N, const EpiArgs& e) {
  const int ntn = N / 128, ntiles = (M / 256) * ntn;
  for (int tile = blockIdx.x; tile < ntiles; tile += gridDim.x) {
    const int tid = threadIdx.x, wid = tid >> 6, lane = tid & 63, wr = wid >> 1, wc = wid & 1, fr = lane & 15, fq = lane >> 4;
    const int row0 = (tile / ntn) * 256 + wr * 64, col0 = (tile % ntn) * 128 + wc * 64;
    f32x4 acc[4][4];
#pragma unroll
    for (int m = 0; m < 4; ++m)
#pragma unroll
        for (int n = 0; n < 4; ++n) acc[m][n] = (f32x4){0.f, 0.f, 0.f, 0.f};
    const bf16_t* ap = A + (size_t)(row0 + fr) * lda + fq * 8;
    const bf16_t* bp = Bt + (size_t)(col0 + fr) * ldb + fq * 8;
    for (int k0 = 0; k0 < K; k0 += 32) {
        bf16x8 a[4], b[4];
#pragma unroll
        for (int m = 0; m < 4; ++m) a[m] = *(const bf16x8*)(ap + (size_t)(m * 16) * lda + k0);
#pragma unroll
        for (int n = 0; n < 4; ++n) b[n] = *(const bf16x8*)(bp + (size_t)(n * 16) * ldb + k0);
#pragma unroll
        for (int m = 0; m < 4; ++m)
#pragma unroll
            for (int n = 0; n < 4; ++n) acc[m][n] = __builtin_amdgcn_mfma_f32_16x16x32_bf16(a[m], b[n], acc[m][n], 0, 0, 0);
    }
#pragma unroll
    for (int m = 0; m < 4; ++m)
#pragma unroll
        for (int n = 0; n < 4; ++n)
#pragma unroll
            for (int j = 0; j < 4; ++j) epi_store<EPI>(e, row0 + m * 16 + fq * 4 + j, col0 + n * 16 + fr, acc[m][n][j]);
  }
}

constexpr int CT = 8;
__device__ __forceinline__ void p_conv(const bf16_t* __restrict__ z, const float* __restrict__ cw, const float* __restrict__ cb,
                                              const float* __restrict__ lng, const float* __restrict__ lnb, bf16_t* __restrict__ uc, float (*sm)[CT]) {
  for (int tile = blockIdx.x; tile < M / CT; tile += gridDim.x) {
    const int c = threadIdx.x, wave = c >> 6, lane = c & 63;
    const int t0 = tile * CT;
    const int s0 = t0 % SEQ;
    float w[CW];
#pragma unroll
    for (int j = 0; j < CW; ++j) w[j] = cw[j * DC + c];
    float acc[CT];
    const float bias = cb[c];
#pragma unroll
    for (int i = 0; i < CT; ++i) acc[i] = bias;
#pragma unroll
    for (int p = 0; p < CT + CW - 1; ++p) {
        const int sp = s0 - (CW - 1) + p;
        float g = 0.f;
        if (sp >= 0) { const size_t r = (size_t)(t0 - (CW - 1) + p); const float a = bf2f(z[r * DIN + O_CVAL + c]), b = bf2f(z[r * DIN + O_CGLU + c]); g = a * sigmoidf_(b); }
#pragma unroll
        for (int i = 0; i < CT; ++i) { const int j = p - i; if (j >= 0 && j < CW) acc[i] += w[j] * g; }
    }
    float red[CT];
#pragma unroll
    for (int i = 0; i < CT; ++i) { float v = acc[i];
#pragma unroll
        for (int o = 1; o < 64; o <<= 1) v += __shfl_xor(v, o);
        red[i] = v; }
    if (lane == 0) {
#pragma unroll
        for (int i = 0; i < CT; ++i) sm[wave][i] = red[i]; }
    __syncthreads();
    float mean[CT];
#pragma unroll
    for (int i = 0; i < CT; ++i) { float s = 0.f;
#pragma unroll
        for (int wv = 0; wv < 8; ++wv) s += sm[wv][i];
        mean[i] = s * (1.0f / DC); }
    __syncthreads();
#pragma unroll
    for (int i = 0; i < CT; ++i) { const float d = acc[i] - mean[i]; float v = d * d;
#pragma unroll
        for (int o = 1; o < 64; o <<= 1) v += __shfl_xor(v, o);
        red[i] = v; }
    if (lane == 0) {
#pragma unroll
        for (int i = 0; i < CT; ++i) sm[wave][i] = red[i]; }
    __syncthreads();
    const float g_ = lng[c], b_ = lnb[c];
#pragma unroll
    for (int i = 0; i < CT; ++i) { float s = 0.f;
#pragma unroll
        for (int wv = 0; wv < 8; ++wv) s += sm[wv][i];
        const float rstd = 1.0f / sqrtf(s * (1.0f / DC) + LN_EPS);
        const float y = (acc[i] - mean[i]) * rstd * g_ + b_;
        const float gate = bf2f(z[(size_t)(t0 + i) * DIN + O_CGATE + c]);
        uc[(size_t)(t0 + i) * DC + c] = (bf16_t)f2bf(siluf_(y) * siluf_(gate)); }
    __syncthreads();
  }
}

__device__ __forceinline__ void p_attn(const bf16_t* __restrict__ z, const float* __restrict__ relb, bf16_t* __restrict__ og) {
  for (int u = blockIdx.x * 8 + (threadIdx.x >> 6); u < BATCH * NCH * NH; u += gridDim.x * 8) {
    const int h = u & 7, n = (u >> 3) & 63, b = u >> 9, i = threadIdx.x & 63;
    const size_t qrow = (size_t)b * SEQ + (size_t)n * CHUNK + i;
    float q[HD], o[HD];
    { const u32x4* qp = (const u32x4*)(z + qrow * DIN + O_Q + h * HD);
#pragma unroll
      for (int d8 = 0; d8 < 8; ++d8) { const u32x4 v = qp[d8];
          q[d8 * 8 + 0] = bflo(v.x) * 0.125f; q[d8 * 8 + 1] = bfhi(v.x) * 0.125f; q[d8 * 8 + 2] = bflo(v.y) * 0.125f; q[d8 * 8 + 3] = bfhi(v.y) * 0.125f;
          q[d8 * 8 + 4] = bflo(v.z) * 0.125f; q[d8 * 8 + 5] = bfhi(v.z) * 0.125f; q[d8 * 8 + 6] = bflo(v.w) * 0.125f; q[d8 * 8 + 7] = bfhi(v.w) * 0.125f; } }
#pragma unroll
    for (int d = 0; d < HD; ++d) o[d] = 0.f;
    float mx = -1e30f, l = 0.f;
    const float* rb = relb + h * N_REL;
    const int w0 = (LEFT - n) > 0 ? (LEFT - n) : 0;
    for (int w = w0; w <= LEFT; ++w) {
        const int kc = n - LEFT + w;
        for (int jj = 0; jj < CHUNK; ++jj) {
            const size_t krow = (size_t)b * SEQ + (size_t)kc * CHUNK + jj;
            const u32x4* kp = (const u32x4*)(z + krow * DIN + O_K + h * HD);
            float s = 0.f;
#pragma unroll
            for (int d8 = 0; d8 < 8; ++d8) { const u32x4 v = kp[d8];
                s += q[d8 * 8 + 0] * bflo(v.x) + q[d8 * 8 + 1] * bfhi(v.x) + q[d8 * 8 + 2] * bflo(v.y) + q[d8 * 8 + 3] * bfhi(v.y)
                   + q[d8 * 8 + 4] * bflo(v.z) + q[d8 * 8 + 5] * bfhi(v.z) + q[d8 * 8 + 6] * bflo(v.w) + q[d8 * 8 + 7] * bfhi(v.w); }
            int rel = LEFT * CHUNK + i - (w * CHUNK + jj); rel = rel < -MAX_REL ? -MAX_REL : (rel > MAX_REL ? MAX_REL : rel);
            s += rb[rel + MAX_REL];
            if (s > mx) { const float a = __expf(mx - s); l *= a;
#pragma unroll
                for (int d = 0; d < HD; ++d) o[d] *= a;
                mx = s; }
            const float p = __expf(s - mx); l += p;
            const u32x4* vp = (const u32x4*)(z + krow * DIN + O_V + h * HD);
#pragma unroll
            for (int d8 = 0; d8 < 8; ++d8) { const u32x4 v = vp[d8];
                o[d8 * 8 + 0] += p * bflo(v.x); o[d8 * 8 + 1] += p * bfhi(v.x); o[d8 * 8 + 2] += p * bflo(v.y); o[d8 * 8 + 3] += p * bfhi(v.y);
                o[d8 * 8 + 4] += p * bflo(v.z); o[d8 * 8 + 5] += p * bfhi(v.z); o[d8 * 8 + 6] += p * bflo(v.w); o[d8 * 8 + 7] += p * bfhi(v.w); }
        }
    }
    const float il = 1.0f / l;
    const u32x4* gp = (const u32x4*)(z + qrow * DIN + O_AG + h * HD);
    u32x4* op = (u32x4*)(og + qrow * DA + h * HD);
#pragma unroll
    for (int d8 = 0; d8 < 8; ++d8) { const u32x4 g = gp[d8]; u32x4 r;
        r.x = pk2(o[d8 * 8 + 0] * il * siluf_(bflo(g.x)), o[d8 * 8 + 1] * il * siluf_(bfhi(g.x)));
        r.y = pk2(o[d8 * 8 + 2] * il * siluf_(bflo(g.y)), o[d8 * 8 + 3] * il * siluf_(bfhi(g.y)));
        r.z = pk2(o[d8 * 8 + 4] * il * siluf_(bflo(g.z)), o[d8 * 8 + 5] * il * siluf_(bfhi(g.z)));
        r.w = pk2(o[d8 * 8 + 6] * il * siluf_(bflo(g.w)), o[d8 * 8 + 7] * il * siluf_(bfhi(g.w)));
        op[d8] = r; }
  }
}

__device__ __forceinline__ void p_ln(float* __restrict__ out, const float* __restrict__ g, const float* __restrict__ bta) {
  for (int row = blockIdx.x * 8 + (threadIdx.x >> 6); row < M; row += gridDim.x * 8) {
    const int lane = threadIdx.x & 63;
    f32x4* p = (f32x4*)(out + (size_t)row * DM) + lane;
    f32x4 v[4]; float s = 0.f;
#pragma unroll
    for (int j = 0; j < 4; ++j) { v[j] = p[64 * j]; s += (v[j].x + v[j].y) + (v[j].z + v[j].w); }
#pragma unroll
    for (int o = 1; o < 64; o <<= 1) s += __shfl_xor(s, o);
    const float mean = s * (1.0f / DM); float s2 = 0.f;
#pragma unroll
    for (int j = 0; j < 4; ++j) { v[j] = v[j] - mean; s2 += (v[j].x * v[j].x + v[j].y * v[j].y) + (v[j].z * v[j].z + v[j].w * v[j].w); }
#pragma unroll
    for (int o = 1; o < 64; o <<= 1) s2 += __shfl_xor(s2, o);
    const float rstd = 1.0f / sqrtf(s2 * (1.0f / DM) + LN_EPS);
#pragma unroll
    for (int j = 0; j < 4; ++j) { const f32x4 gg = ((const f32x4*)g)[lane + 64 * j], bb = ((const f32x4*)bta)[lane + 64 * j]; p[64 * j] = v[j] * rstd * gg + bb; }
  }
}

struct Params { const float* in[14]; float* out; unsigned char* ws; };
__global__ void __launch_bounds__(512) fwd_megakernel(Params p) {
    cg::grid_group grid = cg::this_grid();
    __shared__ float sm[8][CT];
    const float* x = p.in[0]; const float* w_in = p.in[1]; const float* b_in = p.in[2];
    const float* conv_w = p.in[3]; const float* conv_b = p.in[4]; const float* cln_g = p.in[5]; const float* cln_b = p.in[6];
    const float* w_co = p.in[7]; const float* relb = p.in[8]; const float* w_ao = p.in[9];
    const float* w_o = p.in[10]; const float* b_o = p.in[11]; const float* oln_g = p.in[12]; const float* oln_b = p.in[13];
    unsigned char* ws = p.ws; float* out = p.out;
    bf16_t* Win_t = (bf16_t*)(ws + WS_WIN); bf16_t* Wc_t = (bf16_t*)(ws + WS_WC); bf16_t* Wa_t = (bf16_t*)(ws + WS_WA); bf16_t* Wo_t = (bf16_t*)(ws + WS_WO);
    bf16_t* xb = (bf16_t*)(ws + WS_XB); bf16_t* hb = (bf16_t*)(ws + WS_H); bf16_t* z = (bf16_t*)(ws + WS_Z); bf16_t* uc = (bf16_t*)(ws + WS_UC); bf16_t* og = (bf16_t*)(ws + WS_OG);
    p_cvt(x, xb, (size_t)M * DM / 8);
    p_transpose(w_in, Win_t, DM, DIN); p_transpose(w_co, Wc_t, DC, DM); p_transpose(w_ao, Wa_t, DA, DM); p_transpose(w_o, Wo_t, DM, DM);
    grid.sync();
    EpiArgs e{}; e.z = z; e.bias = b_in; e.f32buf = out; e.h = hb; e.x = x;
    p_gemm<0>(xb, DM, Win_t, DM, DM, DIN, e);
    grid.sync();
    p_conv(z, conv_w, conv_b, cln_g, cln_b, uc, sm);
    p_attn(z, relb, og);
    grid.sync();
    p_gemm<1>(uc, DC, Wc_t, DC, DC, DM, e);
    p_gemm<2>(og, DA, Wa_t, DA, DA, DM, e);
    grid.sync();
    e.bias = b_o;
    p_gemm<3>(hb, DM, Wo_t, DM, DM, DM, e);
    grid.sync();
    p_ln(out, oln_g, oln_b);
}

extern "C" void kernel_launch(void* const* d_in, const int* in_sizes, int n_in, void* d_out, int out_size, void* d_ws, size_t ws_size, hipStream_t stream) {
    if (n_in != 14 || in_sizes[0] != M * DM || out_size != M * DM || ws_size < WS_END) { fprintf(stderr, "kernel_launch: unexpected shapes / workspace (n_in %d, ws %zu)\n", n_in, ws_size); return; }
    static int grid_blocks = 0;
    if (!grid_blocks) {
        int dev = 0, cus = 0, per_cu = 0;
        hipGetDevice(&dev);
        hipDeviceGetAttribute(&cus, hipDeviceAttributeMultiprocessorCount, dev);
        hipOccupancyMaxActiveBlocksPerMultiprocessor(&per_cu, fwd_megakernel, 512, 0);
        if (per_cu < 1) { fprintf(stderr, "kernel_launch: occupancy query returned %d\n", per_cu); per_cu = 1; }
        grid_blocks = cus * 1;
    }
    Params p{};
    for (int i = 0; i < 14; ++i) p.in[i] = (const float*)d_in[i];
    p.out = (float*)d_out; p.ws = (unsigned char*)d_ws;
    void* args[] = {&p};
    hipError_t e = hipLaunchCooperativeKernel((void*)fwd_megakernel, dim3(grid_blocks), dim3(512), args, 0, stream);
    if (e != hipSuccess) fprintf(stderr, "cooperative launch failed: %s (grid %d)\n", hipGetErrorString(e), grid_blocks);
}
```

```cpp
#include <hip/hip_runtime.h>
#include <hip/hip_cooperative_groups.h>
namespace cg = cooperative_groups;
#include <cstdio>
#include <cstdint>

typedef unsigned short bf16_t;
typedef short bf16x8 __attribute__((ext_vector_type(8)));
typedef float f32x4 __attribute__((ext_vector_type(4)));
typedef unsigned u32x4 __attribute__((ext_vector_type(4)));

constexpr int BATCH = 8, SEQ = 4096, DM = 1024, M = BATCH * SEQ;
constexpr int DC = 512, DA = 512, NH = 8, HD = 64, CW = 31, DIN = 5632, CHUNK = 64, NCH = SEQ / CHUNK, LEFT = 8;
constexpr int MAX_REL = 128, N_REL = 257;
constexpr int O_CVAL = 0, O_CGLU = 512, O_CGATE = 1024, O_Q = 1536, O_K = 2048, O_V = 2560, O_AG = 3072, O_GC = 3584, O_GA = 4608;
constexpr float LN_EPS = 1e-5f;
constexpr float ALPHA = 1.189207115002721f;

constexpr size_t MiB = 1u << 20;
constexpr size_t WS_WIN = 2 * MiB, WS_WC = 14 * MiB, WS_WA = 15 * MiB, WS_WO = 16 * MiB;
constexpr size_t WS_XB = 32 * MiB;
constexpr size_t WS_H = 32 * MiB;
constexpr size_t WS_Z = 96 * MiB;
constexpr size_t WS_UC = 448 * MiB;
constexpr size_t WS_OG = 480 * MiB;
constexpr size_t WS_END = 512 * MiB;

__device__ __forceinline__ unsigned f2bf(float f) { unsigned u = __builtin_bit_cast(unsigned, f); return (u + 0x7fffu + ((u >> 16) & 1u)) >> 16; }
__device__ __forceinline__ unsigned pk2(float lo, float hi) { return f2bf(lo) | (f2bf(hi) << 16); }
__device__ __forceinline__ float bf2f(bf16_t b) { return __uint_as_float(((unsigned)b) << 16); }
__device__ __forceinline__ float bflo(unsigned w) { return __uint_as_float(w << 16); }
__device__ __forceinline__ float bfhi(unsigned w) { return __uint_as_float(w & 0xffff0000u); }
__device__ __forceinline__ float sigmoidf_(float x) { return 1.0f / (1.0f + __expf(-x)); }
__device__ __forceinline__ float siluf_(float x) { return x / (1.0f + __expf(-x)); }

__device__ __forceinline__ void p_cvt(const float* __restrict__ x, bf16_t* __restrict__ xb, size_t n8) {
    for (size_t i = (size_t)blockIdx.x * blockDim.x + threadIdx.x; i < n8; i += (size_t)gridDim.x * blockDim.x) {
        const f32x4 a = ((const f32x4*)x)[2 * i], b = ((const f32x4*)x)[2 * i + 1];
        u32x4 o; o.x = pk2(a.x, a.y); o.y = pk2(a.z, a.w); o.z = pk2(b.x, b.y); o.w = pk2(b.z, b.w);
        ((u32x4*)xb)[i] = o;
    }
}
__device__ __forceinline__ void p_transpose(const float* __restrict__ W, bf16_t* __restrict__ Wt, int K, int N) {
    const size_t total = (size_t)K * N;
    for (size_t i = (size_t)blockIdx.x * blockDim.x + threadIdx.x; i < total; i += (size_t)gridDim.x * blockDim.x) {
        const int n = (int)(i / K), k = (int)(i % K);
        Wt[i] = (bf16_t)f2bf(W[(size_t)k * N + n]);
    }
}

namespace pg8 {
#define PG8_LAS __attribute__((address_space(3)))
typedef unsigned short bf16_t;
typedef short bf16x8 __attribute__((ext_vector_type(8)));
typedef float f32x4 __attribute__((ext_vector_type(4)));
typedef unsigned u32x4 __attribute__((ext_vector_type(4)));
constexpr int BM = 256, BK = 64, HALF = 128, HTB = HALF * BK * 2  , STAGE_BYTES = 8 * HTB, NXCD = 8, WGM = 8;

__host__ __device__ __forceinline__ int lds_byte(int r, int c) { const int st = (r >> 4) * 2 + (c >> 5), rr = r & 15, cc = c & 31, ob = rr * 64 + cc * 2; return st * 1024 + (ob ^ (((ob >> 9) & 1) << 5)); }
__host__ __device__ __forceinline__ void stage_rc(int b, int& R, int& C) { const int st = b / 1024, sb = b % 1024, swz = sb ^ (((sb >> 9) & 1) << 5); R = (st >> 1) * 16 + swz / 64; C = (st & 1) * 32 + (swz % 64) / 2; }
__host__ __device__ __forceinline__ int perm32(int rho) { const int n = rho >> 4, i = rho & 15; return 8 * (i >> 2) + 4 * n + (i & 3); }

struct Unit { int pm, pn; };
struct Gemm { const bf16_t* A; const bf16_t* Bt; int M, N, K; };

struct StaticOrder {
    int nM, nN, nwg, G, c;
    __host__ __device__ void init(int M, int N, int G_, int c_) { nM = M / BM; nN = N / BM; nwg = nM * nN; G = G_; c = c_; }
    __host__ __device__ bool next(int i, Unit& u) const {
        const long L = (long)i * G + c; if (L >= nwg) return false;
        int wgid = (int)L; { const int q = nwg / NXCD, r = nwg % NXCD, xcd = wgid % NXCD, off = wgid / NXCD; wgid = (xcd < r ? xcd * (q + 1) : r * (q + 1) + (xcd - r) * q) + off; }
        const int nig = WGM * nN, gid = wgid / nig, fm = gid * WGM, gsz = (nM - fm) < WGM ? (nM - fm) : WGM;
        u.pm = fm + ((wgid % nig) % gsz); u.pn = (wgid % nig) / gsz; return true;
    }
    __device__ __forceinline__ void a_ready(const Unit&) const {}
    __device__ __forceinline__ void done(const Unit&) const {}
};

__device__ __forceinline__ unsigned cvt_pk_bf16(float lo, float hi) { unsigned r; asm volatile("v_cvt_pk_bf16_f32 %0, %1, %2" : "=v"(r) : "v"(lo), "v"(hi)); return r; }
typedef float f32x2 __attribute__((ext_vector_type(2)));
__device__ __forceinline__ f32x2 gelu_pk(f32x2 v) {
    const f32x2 av = __builtin_elementwise_abs(v), d = av * 0.2316418882f + 1.0f;
    f32x2 t; t.x = __builtin_amdgcn_rcpf(d.x); t.y = __builtin_amdgcn_rcpf(d.y);
    f32x2 q = t * 0.5307027145f + (-0.7265760135f); q = q * t + 0.7107068705f; q = q * t + (-0.142248368f); q = q * t + 0.127414796f; q = q * t;
    const f32x2 s = (v * v) * (-0.72134752044f);
    f32x2 e; e.x = __builtin_amdgcn_exp2f(s.x); e.y = __builtin_amdgcn_exp2f(s.y);
    const f32x2 m = v * (q * e), r = v - m;
    f32x2 o; o.x = v.x < 0.f ? m.x : r.x; o.y = v.y < 0.f ? m.y : r.y; return o;
}

template <int ACT  > struct EpiBf16 {
    static constexpr bool PERM = true, AFTER_DRAIN = false; static_assert(ACT == 0 || ACT == 1, "EpiBf16: ACT is 0 (none) or 1 (gelu_pk)");
    bf16_t* O; int ldc; const float* bias; int split_cols; size_t split_stride; float scale0;
    __device__ __forceinline__ void operator()(const f32x4 (&acc)[2][2][4][2], const Unit& u, int wr, int wc, int fr, int fq) const {
        const int row0 = u.pm * BM + wr * 64 + fr; int colt = u.pn * BM; bf16_t* base = O;
        float sc = 1.f; if (split_cols) { const int t = colt / split_cols; base += (size_t)t * split_stride; colt -= t * split_cols; if (t == 0) sc = scale0; }
        const int col0 = colt + wc * 32 + 8 * fq, bcol0 = u.pn * BM + wc * 32 + 8 * fq;
        f32x4 bv[2][2];
#pragma unroll
        for (int bj = 0; bj < 2; ++bj)
#pragma unroll
            for (int n = 0; n < 2; ++n) bv[bj][n] = bias ? *(const f32x4*)(bias + bcol0 + bj * HALF + 4 * n) : (f32x4){0.f, 0.f, 0.f, 0.f};
#pragma unroll
        for (int ai = 0; ai < 2; ++ai)
#pragma unroll
            for (int m = 0; m < 4; ++m) { bf16_t* rowp = base + (size_t)(row0 + ai * HALF + m * 16) * ldc + col0;
#pragma unroll
                for (int bj = 0; bj < 2; ++bj) { f32x4 v0 = acc[ai][bj][m][0] + bv[bj][0], v1 = acc[ai][bj][m][1] + bv[bj][1];
                    if (ACT == 1) { f32x2 a = gelu_pk((f32x2){v0[0], v0[1]}), b = gelu_pk((f32x2){v0[2], v0[3]}), c = gelu_pk((f32x2){v1[0], v1[1]}), d = gelu_pk((f32x2){v1[2], v1[3]});
                        v0 = (f32x4){a.x, a.y, b.x, b.y}; v1 = (f32x4){c.x, c.y, d.x, d.y}; }
                    v0 = v0 * sc; v1 = v1 * sc; u32x4 w; w.x = cvt_pk_bf16(v0[0], v0[1]); w.y = cvt_pk_bf16(v0[2], v0[3]); w.z = cvt_pk_bf16(v1[0], v1[1]); w.w = cvt_pk_bf16(v1[2], v1[3]);
                    *(u32x4*)(rowp + bj * HALF) = w; } }
    }
};

struct PanelStats {
    unsigned* xbuf;
    unsigned* cnt;
    unsigned* tmo;
    int ntn; float eps;
    unsigned code;
    __device__ __forceinline__ bool run(const f32x4 (&v)[2][2][4][2], const Unit& u, int wr, int wc, int fr, int fq, PG8_LAS unsigned char* lds, int wid, int lane) const {
        typedef float f32x2v __attribute__((ext_vector_type(2)));
        PG8_LAS f32x2v* P = (PG8_LAS f32x2v*)lds;
        PG8_LAS f32x2v* S = (PG8_LAS f32x2v*)(lds + 8192);
        PG8_LAS unsigned* flag = (PG8_LAS unsigned*)(lds + 8192 + 2048);
#pragma unroll
        for (int ai = 0; ai < 2; ++ai)
#pragma unroll
            for (int m = 0; m < 4; ++m) {
                float s = 0.f;
#pragma unroll
                for (int bj = 0; bj < 2; ++bj)
#pragma unroll
                    for (int n = 0; n < 2; ++n) { const f32x4 x = v[ai][bj][m][n]; s += (x[0] + x[1]) + (x[2] + x[3]); }
                s += __shfl_xor(s, 16); s += __shfl_xor(s, 32);
                const float mw = s * (1.0f / 64.0f); float q = 0.f;
#pragma unroll
                for (int bj = 0; bj < 2; ++bj)
#pragma unroll
                    for (int n = 0; n < 2; ++n) { const f32x4 d = v[ai][bj][m][n] - mw; q += (d[0] * d[0] + d[1] * d[1]) + (d[2] * d[2] + d[3] * d[3]); }
                q += __shfl_xor(q, 16); q += __shfl_xor(q, 32);
                if (fq == 0) P[(ai * HALF + wr * 64 + m * 16 + fr) * 4 + wc] = (f32x2v){mw, q};
            }
        asm volatile("s_waitcnt lgkmcnt(0)" ::: "memory"); __builtin_amdgcn_s_barrier(); asm volatile("" ::: "memory");
#if defined(BROKEN_EXCHANGE_NO_WAIT)
#warning BROKEN CONTROL BUILD: the row-statistics exchange does not wait; results are wrong by design
        if (blockIdx.x >= 64) { const long long t0_ = clock64(); while (clock64() - t0_ < 60000) __builtin_amdgcn_s_sleep(8); }
#endif
        const int row = wid * 32 + (lane & 31);
        if (lane < 32) {
            const f32x2v a = P[row * 4 + 0], b = P[row * 4 + 1], c = P[row * 4 + 2], d = P[row * 4 + 3];
            const float mt = (a.x + b.x + c.x + d.x) * 0.25f;
            const float da = a.x - mt, db = b.x - mt, dc = c.x - mt, dd = d.x - mt;
            const float m2 = (a.y + b.y) + (c.y + d.y) + 64.0f * ((da * da + db * db) + (dc * dc + dd * dd));
            unsigned long long* slot = (unsigned long long*)xbuf + ((size_t)(u.pm * BM + row) * 4 + u.pn);
            __hip_atomic_store(slot, ((unsigned long long)__float_as_uint(m2) << 32) | __float_as_uint(mt), __ATOMIC_RELAXED, __HIP_MEMORY_SCOPE_AGENT);
        }
        asm volatile("s_waitcnt vmcnt(0)" ::: "memory");
        if (lane == 0) __hip_atomic_fetch_add(cnt + 64 * u.pm, 1u, __ATOMIC_RELAXED, __HIP_MEMORY_SCOPE_AGENT);
        if (wid == 0) {
            bool dead = false; const unsigned long long t0 = __builtin_amdgcn_s_memrealtime(); const unsigned want = 8u * (unsigned)ntn;
            for (;;) {
#if defined(BROKEN_EXCHANGE_NO_WAIT)
                break;
#endif
                if ((unsigned)__builtin_amdgcn_readfirstlane(__hip_atomic_load(cnt + 64 * u.pm, __ATOMIC_RELAXED, __HIP_MEMORY_SCOPE_AGENT)) >= want) break;
                if (__builtin_amdgcn_s_memrealtime() - t0 > 2000000ull) {
                    if (lane == 0) { unsigned expect = 0u; __hip_atomic_compare_exchange_strong(tmo + 1, &expect, code | (unsigned)(u.pm & 0xff), __ATOMIC_RELAXED, __ATOMIC_RELAXED, __HIP_MEMORY_SCOPE_AGENT);
                                     __hip_atomic_store(tmo, 1u, __ATOMIC_RELAXED, __HIP_MEMORY_SCOPE_AGENT); }
                    dead = true; break; }
                __builtin_amdgcn_s_sleep(2);
            }
            __builtin_amdgcn_fence(__ATOMIC_ACQUIRE, "agent");
            if (lane == 0) flag[0] = dead ? 1u : 0u;
        }
        asm volatile("s_waitcnt vmcnt(0) lgkmcnt(0)" ::: "memory"); __builtin_amdgcn_s_barrier(); asm volatile("" ::: "memory");
        const bool bad = flag[0] != 0u;
        if (lane < 32) {
            const unsigned long long* slot = (const unsigned long long*)xbuf + (size_t)(u.pm * BM + row) * 4; float mt[4], m2[4]; float ms = 0.f;
#pragma unroll
            for (int t = 0; t < 4; ++t) { if (t < ntn) { const unsigned long long w = __hip_atomic_load(slot + t, __ATOMIC_RELAXED, __HIP_MEMORY_SCOPE_AGENT); mt[t] = __uint_as_float((unsigned)w); m2[t] = __uint_as_float((unsigned)(w >> 32)); } else { mt[t] = 0.f; m2[t] = 0.f; } ms += mt[t]; }
            const float mean = ms / (float)ntn; float q = 0.f;
#pragma unroll
            for (int t = 0; t < 4; ++t) if (t < ntn) { const float dm = mt[t] - mean; q += m2[t] + 256.0f * dm * dm; }
            S[row] = (f32x2v){mean, 1.0f / sqrtf(q / (256.0f * (float)ntn) + eps)};
        }
        asm volatile("s_waitcnt lgkmcnt(0)" ::: "memory"); __builtin_amdgcn_s_barrier(); asm volatile("" ::: "memory");
        return bad;
    }
};
struct EpiLnRes {
    static constexpr bool PERM = false, AFTER_DRAIN = true;
    const float* base; float* out; int ldc; const float* bias; PanelStats st; unsigned poison;
    __device__ __forceinline__ void fused(f32x4 (&acc)[2][2][4][2], const Unit& u, int wr, int wc, int fr, int fq, PG8_LAS unsigned char* lds, int wid, int lane) const {
        typedef float f32x2v __attribute__((ext_vector_type(2)));
        const PG8_LAS f32x2v* S = (const PG8_LAS f32x2v*)(lds + 8192);
        const int col0 = u.pn * BM + wc * 32 + 4 * fq;
#pragma unroll
        for (int bj = 0; bj < 2; ++bj)
#pragma unroll
            for (int n = 0; n < 2; ++n) { const f32x4 bv = bias ? *(const f32x4*)(bias + col0 + bj * HALF + n * 16) : (f32x4){0.f, 0.f, 0.f, 0.f};
#pragma unroll
                for (int ai = 0; ai < 2; ++ai)
#pragma unroll
                    for (int m = 0; m < 4; ++m) acc[ai][bj][m][n] += bv; }
        f32x4 pre[4][2][2];
#pragma unroll
        for (int m = 0; m < 4; ++m) { const size_t off = (size_t)(u.pm * BM + wr * 64 + m * 16 + fr) * ldc + col0;
#pragma unroll
            for (int bj = 0; bj < 2; ++bj)
#pragma unroll
                for (int n = 0; n < 2; ++n) pre[m][bj][n] = *(const f32x4*)(base + off + bj * HALF + n * 16); }
        const bool bad = st.run(acc, u, wr, wc, fr, fq, lds, wid, lane) || poison != 0u;
        const float qnan = __builtin_nanf("");
#pragma unroll
        for (int ai = 0; ai < 2; ++ai)
#pragma unroll
            for (int m = 0; m < 4; ++m) { const int r = ai * HALF + wr * 64 + m * 16 + fr; const f32x2v sr = S[r]; const size_t off = (size_t)(u.pm * BM + r) * ldc + col0;
#pragma unroll
                for (int bj = 0; bj < 2; ++bj)
#pragma unroll
                    for (int n = 0; n < 2; ++n) { const f32x4 bs = ai == 0 ? pre[m][bj][n] : *(const f32x4*)(base + off + bj * HALF + n * 16); f32x4 o = bs + (acc[ai][bj][m][n] - sr.x) * sr.y;
                        if (bad) o = (f32x4){qnan, qnan, qnan, qnan}; *(f32x4*)(out + off + bj * HALF + n * 16) = o; }
                if (m & 1) asm volatile("" ::: "memory"); }
    }
};
struct EpiLnResLn {
    static constexpr bool PERM = false, AFTER_DRAIN = true;
    const float* base; float* out; bf16_t* xn; int ldc; const float* bias; PanelStats st1, st2; unsigned poison;
    __device__ __forceinline__ void fused(f32x4 (&acc)[2][2][4][2], const Unit& u, int wr, int wc, int fr, int fq, PG8_LAS unsigned char* lds, int wid, int lane) const {
        typedef float f32x2v __attribute__((ext_vector_type(2))); typedef unsigned u32x2v __attribute__((ext_vector_type(2)));
        const PG8_LAS f32x2v* S = (const PG8_LAS f32x2v*)(lds + 8192);
        const int col0 = u.pn * BM + wc * 32 + 4 * fq;
#pragma unroll
        for (int bj = 0; bj < 2; ++bj)
#pragma unroll
            for (int n = 0; n < 2; ++n) { const f32x4 bv = bias ? *(const f32x4*)(bias + col0 + bj * HALF + n * 16) : (f32x4){0.f, 0.f, 0.f, 0.f};
#pragma unroll
                for (int ai = 0; ai < 2; ++ai)
#pragma unroll
                    for (int m = 0; m < 4; ++m) acc[ai][bj][m][n] += bv; }
        bool bad = st1.run(acc, u, wr, wc, fr, fq, lds, wid, lane) || poison != 0u;
        const float qnan = __builtin_nanf("");
#pragma unroll
        for (int ai = 0; ai < 2; ++ai)
#pragma unroll
            for (int m = 0; m < 4; ++m) { const int r = ai * HALF + wr * 64 + m * 16 + fr; const f32x2v sr = S[r]; const size_t off = (size_t)(u.pm * BM + r) * ldc + col0;
#pragma unroll
                for (int bj = 0; bj < 2; ++bj)
#pragma unroll
                    for (int n = 0; n < 2; ++n) { const f32x4 bs = *(const f32x4*)(base + off + bj * HALF + n * 16); acc[ai][bj][m][n] = bs + (acc[ai][bj][m][n] - sr.x) * sr.y; }
                asm volatile("" : "+v"(acc[ai][0][m][0]), "+v"(acc[ai][0][m][1]), "+v"(acc[ai][1][m][0]), "+v"(acc[ai][1][m][1]));
                if (m & 1) asm volatile("" ::: "memory"); }
        const bool bad1 = bad;
        bad = st2.run(acc, u, wr, wc, fr, fq, lds, wid, lane) || bad;
#pragma unroll
        for (int ai = 0; ai < 2; ++ai)
#pragma unroll
            for (int m = 0; m < 4; ++m) { const int r = ai * HALF + wr * 64 + m * 16 + fr; const f32x2v sr = S[r]; const size_t off = (size_t)(u.pm * BM + r) * ldc + col0;
#pragma unroll
                for (int bj = 0; bj < 2; ++bj)
#pragma unroll
                    for (int n = 0; n < 2; ++n) { const f32x4 x1 = acc[ai][bj][m][n]; *(f32x4*)(out + off + bj * HALF + n * 16) = bad1 ? (f32x4){qnan, qnan, qnan, qnan} : x1;
                        const f32x4 o = (x1 - sr.x) * sr.y; u32x2v w; w.x = cvt_pk_bf16(o[0], o[1]); w.y = cvt_pk_bf16(o[2], o[3]);
                        if (bad) { w.x = 0x7fc07fc0u; w.y = 0x7fc07fc0u; } *(u32x2v*)(xn + off + bj * HALF + n * 16) = w; }
                asm volatile("" ::: "memory"); }
    }
};

template <class Epi, class Sched, bool ALIGN_EPI = false, bool SP2 = false>
__device__ __forceinline__ void gemm_phase(PG8_LAS unsigned char* lds, const Gemm g, const Sched& S, const Epi& E) {
    const int tid = threadIdx.x, wid = __builtin_amdgcn_readfirstlane(tid >> 6), lane = tid & 63, wr = wid >> 2, wc = wid & 3, fr = lane & 15, fq = lane >> 4;
    const int K = g.K, nt = K / BK;
    unsigned voffA[2], voffB[2];
#pragma unroll
    for (int i = 0; i < 2; ++i) { int R, C; stage_rc(tid * 16 + i * 8192, R, C); const int Rb = Epi::PERM ? ((R & ~31) + perm32(R & 31)) : R;
        voffA[i] = (unsigned)(R * K + C) * 2u; voffB[i] = (unsigned)(Rb * K + C) * 2u; }
    const size_t kstep = (size_t)(BK * 2);
    const size_t hstep = (size_t)HALF * K * 2;
    const size_t tstep = 2 * hstep;
    const unsigned ldsw = (unsigned)wid * 1024u;
    const int aoff = lds_byte(wr * 64 + fr, fq * 8), boff = lds_byte(wc * 32 + fr, fq * 8);
#define PG8_SA(b, h) (((b) * 2 + (h)) * HTB)
#define PG8_SB(b, h) ((4 + (b) * 2 + (h)) * HTB)
#define PG8_STAGE(bufoff, gbase, voff) do { _Pragma("unroll") for (int _i = 0; _i < 2; ++_i) \
        __builtin_amdgcn_global_load_lds((const unsigned*)((const char*)(gbase) + (voff)[_i]), (PG8_LAS unsigned*)(lds + (bufoff) + ldsw + _i * 8192), 16, 0, 0); } while (0)
#define PG8_LDA(dst, b, h) do { _Pragma("unroll") for (int m = 0; m < 4; ++m) _Pragma("unroll") for (int k = 0; k < 2; ++k) dst[m][k] = *(const PG8_LAS bf16x8*)(lds + PG8_SA(b, h) + aoff + m * 2048 + k * 1024); } while (0)
#define PG8_LDB(dst, b, h) do { _Pragma("unroll") for (int n = 0; n < 2; ++n) _Pragma("unroll") for (int k = 0; k < 2; ++k) dst[n][k] = *(const PG8_LAS bf16x8*)(lds + PG8_SB(b, h) + boff + n * 2048 + k * 1024); } while (0)
#define PG8_MMA(ai, bj, At, Bt) do { __builtin_amdgcn_s_setprio(1); _Pragma("unroll") for (int m = 0; m < 4; ++m) _Pragma("unroll") for (int n = 0; n < 2; ++n) _Pragma("unroll") for (int k = 0; k < 2; ++k) \
        acc[ai][bj][m][n] = __builtin_amdgcn_mfma_f32_16x16x32_bf16(Bt[n][k], At[m][k], acc[ai][bj][m][n], 0, 0, 0); __builtin_amdgcn_s_setprio(0); } while (0)
#define PG8_WAIT_V(n) asm volatile("s_waitcnt vmcnt(" #n ")" ::: "memory")
#define PG8_WAIT_L(n) asm volatile("s_waitcnt lgkmcnt(" #n ")" ::: "memory")
#define PG8_BAR __builtin_amdgcn_s_barrier()
#define PG8_SCHED __builtin_amdgcn_sched_barrier(0)
    Unit cur, nxt; int ui = 0;
    if (!S.next(0, cur)) return;
    f32x4 acc[2][2][4][2];
#pragma unroll
    for (int a = 0; a < 2; ++a)
#pragma unroll
        for (int b = 0; b < 2; ++b)
#pragma unroll
            for (int m = 0; m < 4; ++m)
#pragma unroll
                for (int n = 0; n < 2; ++n) acc[a][b][m][n] = (f32x4){0.f, 0.f, 0.f, 0.f};
    bf16x8 At[4][2], B0[2][2], B1[2][2];
    const char* cA = (const char*)g.A + (size_t)cur.pm * tstep; const char* cB = (const char*)g.Bt + (size_t)cur.pn * tstep;
    S.a_ready(cur);
    if constexpr (SP2) {
        PG8_STAGE(PG8_SB(0, 0), cB, voffB); PG8_STAGE(PG8_SB(0, 1), cB + hstep, voffB); PG8_STAGE(PG8_SA(0, 0), cA, voffA); PG8_STAGE(PG8_SA(0, 1), cA + hstep, voffA);
        if (wr == 1) PG8_BAR;
        PG8_WAIT_V(2); PG8_BAR;
        PG8_STAGE(PG8_SB(1, 0), cB + kstep, voffB); PG8_STAGE(PG8_SA(1, 0), cA + kstep, voffA); PG8_STAGE(PG8_SB(1, 1), cB + hstep + kstep, voffB);
        PG8_WAIT_V(6); PG8_BAR;
    } else {
        PG8_STAGE(PG8_SB(0, 0), cB, voffB); PG8_STAGE(PG8_SA(0, 0), cA, voffA); PG8_STAGE(PG8_SB(0, 1), cB + hstep, voffB); PG8_STAGE(PG8_SA(0, 1), cA + hstep, voffA);
        if (wr == 1) PG8_BAR;
        PG8_WAIT_V(4); PG8_BAR;
        PG8_STAGE(PG8_SB(1, 0), cB + kstep, voffB); PG8_STAGE(PG8_SA(1, 0), cA + kstep, voffA); PG8_STAGE(PG8_SB(1, 1), cB + hstep + kstep, voffB);
        PG8_WAIT_V(6); PG8_BAR;
    }
    for (;;) {
        const bool has_next = S.next(ui + 1, nxt);
        const char* nA = has_next ? (const char*)g.A + (size_t)nxt.pm * tstep : cA; const char* nB = has_next ? (const char*)g.Bt + (size_t)nxt.pn * tstep : cB;
        for (int t = 0; t < nt; t += 2) {
            const bool last = (t == nt - 2);
            const char* a1 = cA + (size_t)(t + 1) * kstep;
            const char* a2 = last ? nA : cA + (size_t)(t + 2) * kstep; const char* b2 = last ? nB : cB + (size_t)(t + 2) * kstep;
            const char* a3 = a2 + kstep; const char* b3 = b2 + kstep;
            if (last && has_next) S.a_ready(nxt);
            if constexpr (SP2) {
            PG8_LDB(B0, 0, 0); PG8_LDB(B1, 0, 1); PG8_SCHED; PG8_LDA(At, 0, 0); PG8_STAGE(PG8_SA(1, 1), a1 + hstep, voffA);
            PG8_WAIT_V(8); PG8_WAIT_L(0); PG8_BAR; PG8_MMA(0, 0, At, B0); PG8_MMA(0, 1, At, B1); PG8_BAR; PG8_SCHED;
            PG8_LDA(At, 0, 1); PG8_STAGE(PG8_SB(0, 0), b2, voffB); PG8_STAGE(PG8_SB(0, 1), b2 + hstep, voffB); PG8_STAGE(PG8_SA(0, 0), a2, voffA);
            PG8_WAIT_V(8); PG8_WAIT_L(0); PG8_BAR; PG8_MMA(1, 0, At, B0); PG8_MMA(1, 1, At, B1); PG8_BAR; PG8_SCHED;
            PG8_LDB(B0, 1, 0); PG8_LDB(B1, 1, 1); PG8_SCHED; PG8_LDA(At, 1, 0); PG8_STAGE(PG8_SA(0, 1), a2 + hstep, voffA);
            PG8_WAIT_V(8); PG8_WAIT_L(0); PG8_BAR; PG8_MMA(0, 0, At, B0); PG8_MMA(0, 1, At, B1); PG8_BAR; PG8_SCHED;
            PG8_LDA(At, 1, 1); PG8_STAGE(PG8_SB(1, 0), b3, voffB); PG8_STAGE(PG8_SB(1, 1), b3 + hstep, voffB); PG8_STAGE(PG8_SA(1, 0), a3, voffA);
            PG8_WAIT_V(8); PG8_WAIT_L(0); PG8_BAR; PG8_MMA(1, 0, At, B0); PG8_MMA(1, 1, At, B1); PG8_BAR; PG8_SCHED;
            } else {
            PG8_LDB(B0, 0, 0); PG8_SCHED; PG8_LDA(At, 0, 0); PG8_STAGE(PG8_SA(1, 1), a1 + hstep, voffA);
            PG8_WAIT_L(8); PG8_BAR; PG8_WAIT_L(0); PG8_MMA(0, 0, At, B0); PG8_BAR; PG8_SCHED;
            PG8_LDB(B1, 0, 1); PG8_STAGE(PG8_SB(0, 0), b2, voffB);
            PG8_BAR; PG8_WAIT_L(0); PG8_MMA(0, 1, At, B1); PG8_BAR;
            PG8_LDA(At, 0, 1); PG8_STAGE(PG8_SA(0, 0), a2, voffA);
            PG8_BAR; PG8_WAIT_L(0); PG8_MMA(1, 0, At, B0); PG8_BAR; PG8_SCHED;
            PG8_STAGE(PG8_SB(0, 1), b2 + hstep, voffB);
            PG8_WAIT_V(6); PG8_BAR; PG8_MMA(1, 1, At, B1); PG8_BAR;
            PG8_LDB(B0, 1, 0); PG8_SCHED; PG8_LDA(At, 1, 0); PG8_STAGE(PG8_SA(0, 1), a2 + hstep, voffA);
            PG8_WAIT_L(8); PG8_BAR; PG8_WAIT_L(0); PG8_MMA(0, 0, At, B0); PG8_BAR; PG8_SCHED;
            PG8_LDB(B1, 1, 1); PG8_STAGE(PG8_SB(1, 0), b3, voffB);
            PG8_BAR; PG8_WAIT_L(0); PG8_MMA(0, 1, At, B1); PG8_BAR;
            PG8_LDA(At, 1, 1); PG8_STAGE(PG8_SA(1, 0), a3, voffA);
            PG8_BAR; PG8_WAIT_L(0); PG8_MMA(1, 0, At, B0); PG8_BAR; PG8_SCHED;
            PG8_STAGE(PG8_SB(1, 1), b3 + hstep, voffB);
            PG8_WAIT_V(6); PG8_BAR; PG8_MMA(1, 1, At, B1); PG8_BAR;
            }
        }
        if constexpr (ALIGN_EPI) { if (wr == 0) PG8_BAR; }
        if constexpr (!Epi::AFTER_DRAIN) { E(acc, cur, wr, wc, fr, fq); S.done(cur); }
        if (!has_next) break;
#pragma unroll
        for (int a = 0; a < 2; ++a)
#pragma unroll
            for (int b = 0; b < 2; ++b)
#pragma unroll
                for (int m = 0; m < 4; ++m)
#pragma unroll
                    for (int n = 0; n < 2; ++n) acc[a][b][m][n] = (f32x4){0.f, 0.f, 0.f, 0.f};
        cur = nxt; cA = nA; cB = nB; ++ui;
        if constexpr (ALIGN_EPI) { if (wr == 1) PG8_BAR; }
    }
    PG8_WAIT_V(0);
    if constexpr (!ALIGN_EPI) { if (wr == 0) PG8_BAR; }
    PG8_BAR;
    if constexpr (Epi::AFTER_DRAIN) { E.fused(acc, cur, wr, wc, fr, fq, lds, wid, lane); S.done(cur); }
#undef PG8_SA
#undef PG8_SB
#undef PG8_STAGE
#undef PG8_LDA
#undef PG8_LDB
#undef PG8_MMA
#undef PG8_WAIT_V
#undef PG8_WAIT_L
#undef PG8_BAR
#undef PG8_SCHED
}
}

#ifndef PG8_SP2
#define PG8_SP2 true
#endif
#ifndef PG8_ALIGN
#define PG8_ALIGN true
#endif

namespace pg8 {
__device__ __forceinline__ float sigm(float x) { return __builtin_amdgcn_rcpf(1.0f + __expf(-x)); }
struct EpiGate1 {
    static constexpr bool PERM = true, AFTER_DRAIN = false;
    float* T; const bf16_t* z; int gcol;
    __device__ __forceinline__ void operator()(const f32x4 (&acc)[2][2][4][2], const Unit& u, int wr, int wc, int fr, int fq) const {
        const int row0 = u.pm * BM + wr * 64 + fr, col0 = u.pn * BM + wc * 32 + 8 * fq;
#pragma unroll
        for (int ai = 0; ai < 2; ++ai)
#pragma unroll
            for (int m = 0; m < 4; ++m) { const size_t r = (size_t)(row0 + ai * HALF + m * 16);
#pragma unroll
                for (int bj = 0; bj < 2; ++bj) { const int c = col0 + bj * HALF;
                    const u32x4 g = *(const u32x4*)(z + r * DIN + gcol + c);
                    const f32x4 s0 = {sigm(bflo(g.x)), sigm(bfhi(g.x)), sigm(bflo(g.y)), sigm(bfhi(g.y))}, s1 = {sigm(bflo(g.z)), sigm(bfhi(g.z)), sigm(bflo(g.w)), sigm(bfhi(g.w))};
                    *(f32x4*)(T + r * DM + c) = acc[ai][bj][m][0] * s0; *(f32x4*)(T + r * DM + c + 4) = acc[ai][bj][m][1] * s1; } }
    }
};
struct EpiGate2 {
    static constexpr bool PERM = true, AFTER_DRAIN = false;
    const float* T; const bf16_t* z; int gcol; bf16_t* H;
    __device__ __forceinline__ void operator()(const f32x4 (&acc)[2][2][4][2], const Unit& u, int wr, int wc, int fr, int fq) const {
        const int row0 = u.pm * BM + wr * 64 + fr, col0 = u.pn * BM + wc * 32 + 8 * fq;
#pragma unroll
        for (int ai = 0; ai < 2; ++ai)
#pragma unroll
            for (int m = 0; m < 4; ++m) { const size_t r = (size_t)(row0 + ai * HALF + m * 16);
#pragma unroll
                for (int bj = 0; bj < 2; ++bj) { const int c = col0 + bj * HALF;
                    const u32x4 g = *(const u32x4*)(z + r * DIN + gcol + c);
                    const f32x4 s0 = {sigm(bflo(g.x)), sigm(bfhi(g.x)), sigm(bflo(g.y)), sigm(bfhi(g.y))}, s1 = {sigm(bflo(g.z)), sigm(bfhi(g.z)), sigm(bflo(g.w)), sigm(bfhi(g.w))};
                    const f32x4 v0 = *(const f32x4*)(T + r * DM + c) + acc[ai][bj][m][0] * s0, v1 = *(const f32x4*)(T + r * DM + c + 4) + acc[ai][bj][m][1] * s1;
                    u32x4 w; w.x = cvt_pk_bf16(v0[0], v0[1]); w.y = cvt_pk_bf16(v0[2], v0[3]); w.z = cvt_pk_bf16(v1[0], v1[1]); w.w = cvt_pk_bf16(v1[2], v1[3]);
                    *(u32x4*)(H + r * DM + c) = w; } }
    }
};
struct EpiRes {
    static constexpr bool PERM = false, AFTER_DRAIN = false;
    float* C; const float* X; const float* bias;
    __device__ __forceinline__ void operator()(const f32x4 (&acc)[2][2][4][2], const Unit& u, int wr, int wc, int fr, int fq) const {
        const int row0 = u.pm * BM + wr * 64 + fr, col0 = u.pn * BM + wc * 32 + 4 * fq;
        f32x4 bv[2][2];
#pragma unroll
        for (int bj = 0; bj < 2; ++bj)
#pragma unroll
            for (int n = 0; n < 2; ++n) bv[bj][n] = *(const f32x4*)(bias + col0 + bj * HALF + n * 16);
#pragma unroll
        for (int ai = 0; ai < 2; ++ai)
#pragma unroll
            for (int m = 0; m < 4; ++m) { const size_t off = (size_t)(row0 + ai * HALF + m * 16) * DM + col0;
#pragma unroll
                for (int bj = 0; bj < 2; ++bj)
#pragma unroll
                    for (int n = 0; n < 2; ++n) *(f32x4*)(C + off + bj * HALF + n * 16) = *(const f32x4*)(X + off + bj * HALF + n * 16) * ALPHA + acc[ai][bj][m][n] + bv[bj][n]; }
    }
};
}

constexpr int CT = 8;
__device__ __forceinline__ void p_conv(const bf16_t* __restrict__ z, const float* __restrict__ cw, const float* __restrict__ cb,
                                              const float* __restrict__ lng, const float* __restrict__ lnb, bf16_t* __restrict__ uc, float (*sm)[CT]) {
  for (int tile = blockIdx.x; tile < M / CT; tile += gridDim.x) {
    const int c = threadIdx.x, wave = c >> 6, lane = c & 63;
    const int t0 = tile * CT;
    const int s0 = t0 % SEQ;
    float w[CW];
#pragma unroll
    for (int j = 0; j < CW; ++j) w[j] = cw[j * DC + c];
    float acc[CT];
    const float bias = cb[c];
#pragma unroll
    for (int i = 0; i < CT; ++i) acc[i] = bias;
#pragma unroll
    for (int p = 0; p < CT + CW - 1; ++p) {
        const int sp = s0 - (CW - 1) + p;
        float g = 0.f;
        if (sp >= 0) { const size_t r = (size_t)(t0 - (CW - 1) + p); const float a = bf2f(z[r * DIN + O_CVAL + c]), b = bf2f(z[r * DIN + O_CGLU + c]); g = a * sigmoidf_(b); }
#pragma unroll
        for (int i = 0; i < CT; ++i) { const int j = p - i; if (j >= 0 && j < CW) acc[i] += w[j] * g; }
    }
    float red[CT];
#pragma unroll
    for (int i = 0; i < CT; ++i) { float v = acc[i];
#pragma unroll
        for (int o = 1; o < 64; o <<= 1) v += __shfl_xor(v, o);
        red[i] = v; }
    if (lane == 0) {
#pragma unroll
        for (int i = 0; i < CT; ++i) sm[wave][i] = red[i]; }
    __syncthreads();
    float mean[CT];
#pragma unroll
    for (int i = 0; i < CT; ++i) { float s = 0.f;
#pragma unroll
        for (int wv = 0; wv < 8; ++wv) s += sm[wv][i];
        mean[i] = s * (1.0f / DC); }
    __syncthreads();
#pragma unroll
    for (int i = 0; i < CT; ++i) { const float d = acc[i] - mean[i]; float v = d * d;
#pragma unroll
        for (int o = 1; o < 64; o <<= 1) v += __shfl_xor(v, o);
        red[i] = v; }
    if (lane == 0) {
#pragma unroll
        for (int i = 0; i < CT; ++i) sm[wave][i] = red[i]; }
    __syncthreads();
    const float g_ = lng[c], b_ = lnb[c];
#pragma unroll
    for (int i = 0; i < CT; ++i) { float s = 0.f;
#pragma unroll
        for (int wv = 0; wv < 8; ++wv) s += sm[wv][i];
        const float rstd = 1.0f / sqrtf(s * (1.0f / DC) + LN_EPS);
        const float y = (acc[i] - mean[i]) * rstd * g_ + b_;
        const float gate = bf2f(z[(size_t)(t0 + i) * DIN + O_CGATE + c]);
        uc[(size_t)(t0 + i) * DC + c] = (bf16_t)f2bf(siluf_(y) * siluf_(gate)); }
    __syncthreads();
  }
}

__device__ __forceinline__ void p_attn(const bf16_t* __restrict__ z, const float* __restrict__ relb, bf16_t* __restrict__ og) {
  for (int u = blockIdx.x * 8 + (threadIdx.x >> 6); u < BATCH * NCH * NH; u += gridDim.x * 8) {
    const int h = u & 7, n = (u >> 3) & 63, b = u >> 9, i = threadIdx.x & 63;
    const size_t qrow = (size_t)b * SEQ + (size_t)n * CHUNK + i;
    float q[HD], o[HD];
    { const u32x4* qp = (const u32x4*)(z + qrow * DIN + O_Q + h * HD);
#pragma unroll
      for (int d8 = 0; d8 < 8; ++d8) { const u32x4 v = qp[d8];
          q[d8 * 8 + 0] = bflo(v.x) * 0.125f; q[d8 * 8 + 1] = bfhi(v.x) * 0.125f; q[d8 * 8 + 2] = bflo(v.y) * 0.125f; q[d8 * 8 + 3] = bfhi(v.y) * 0.125f;
          q[d8 * 8 + 4] = bflo(v.z) * 0.125f; q[d8 * 8 + 5] = bfhi(v.z) * 0.125f; q[d8 * 8 + 6] = bflo(v.w) * 0.125f; q[d8 * 8 + 7] = bfhi(v.w) * 0.125f; } }
#pragma unroll
    for (int d = 0; d < HD; ++d) o[d] = 0.f;
    float mx = -1e30f, l = 0.f;
    const float* rb = relb + h * N_REL;
    const int w0 = (LEFT - n) > 0 ? (LEFT - n) : 0;
    for (int w = w0; w <= LEFT; ++w) {
        const int kc = n - LEFT + w;
        for (int jj = 0; jj < CHUNK; ++jj) {
            const size_t krow = (size_t)b * SEQ + (size_t)kc * CHUNK + jj;
            const u32x4* kp = (const u32x4*)(z + krow * DIN + O_K + h * HD);
            float s = 0.f;
#pragma unroll
            for (int d8 = 0; d8 < 8; ++d8) { const u32x4 v = kp[d8];
                s += q[d8 * 8 + 0] * bflo(v.x) + q[d8 * 8 + 1] * bfhi(v.x) + q[d8 * 8 + 2] * bflo(v.y) + q[d8 * 8 + 3] * bfhi(v.y)
                   + q[d8 * 8 + 4] * bflo(v.z) + q[d8 * 8 + 5] * bfhi(v.z) + q[d8 * 8 + 6] * bflo(v.w) + q[d8 * 8 + 7] * bfhi(v.w); }
            int rel = LEFT * CHUNK + i - (w * CHUNK + jj); rel = rel < -MAX_REL ? -MAX_REL : (rel > MAX_REL ? MAX_REL : rel);
            s += rb[rel + MAX_REL];
            if (s > mx) { const float a = __expf(mx - s); l *= a;
#pragma unroll
                for (int d = 0; d < HD; ++d) o[d] *= a;
                mx = s; }
            const float p = __expf(s - mx); l += p;
            const u32x4* vp = (const u32x4*)(z + krow * DIN + O_V + h * HD);
#pragma unroll
            for (int d8 = 0; d8 < 8; ++d8) { const u32x4 v = vp[d8];
                o[d8 * 8 + 0] += p * bflo(v.x); o[d8 * 8 + 1] += p * bfhi(v.x); o[d8 * 8 + 2] += p * bflo(v.y); o[d8 * 8 + 3] += p * bfhi(v.y);
                o[d8 * 8 + 4] += p * bflo(v.z); o[d8 * 8 + 5] += p * bfhi(v.z); o[d8 * 8 + 6] += p * bflo(v.w); o[d8 * 8 + 7] += p * bfhi(v.w); }
        }
    }
    const float il = 1.0f / l;
    const u32x4* gp = (const u32x4*)(z + qrow * DIN + O_AG + h * HD);
    u32x4* op = (u32x4*)(og + qrow * DA + h * HD);
#pragma unroll
    for (int d8 = 0; d8 < 8; ++d8) { const u32x4 g = gp[d8]; u32x4 r;
        r.x = pk2(o[d8 * 8 + 0] * il * siluf_(bflo(g.x)), o[d8 * 8 + 1] * il * siluf_(bfhi(g.x)));
        r.y = pk2(o[d8 * 8 + 2] * il * siluf_(bflo(g.y)), o[d8 * 8 + 3] * il * siluf_(bfhi(g.y)));
        r.z = pk2(o[d8 * 8 + 4] * il * siluf_(bflo(g.z)), o[d8 * 8 + 5] * il * siluf_(bfhi(g.z)));
        r.w = pk2(o[d8 * 8 + 6] * il * siluf_(bflo(g.w)), o[d8 * 8 + 7] * il * siluf_(bfhi(g.w)));
        op[d8] = r; }
  }
}

__device__ __forceinline__ void p_ln(float* __restrict__ out, const float* __restrict__ g, const float* __restrict__ bta) {
  for (int row = blockIdx.x * 8 + (threadIdx.x >> 6); row < M; row += gridDim.x * 8) {
    const int lane = threadIdx.x & 63;
    f32x4* p = (f32x4*)(out + (size_t)row * DM) + lane;
    f32x4 v[4]; float s = 0.f;
#pragma unroll
    for (int j = 0; j < 4; ++j) { v[j] = p[64 * j]; s += (v[j].x + v[j].y) + (v[j].z + v[j].w); }
#pragma unroll
    for (int o = 1; o < 64; o <<= 1) s += __shfl_xor(s, o);
    const float mean = s * (1.0f / DM); float s2 = 0.f;
#pragma unroll
    for (int j = 0; j < 4; ++j) { v[j] = v[j] - mean; s2 += (v[j].x * v[j].x + v[j].y * v[j].y) + (v[j].z * v[j].z + v[j].w * v[j].w); }
#pragma unroll
    for (int o = 1; o < 64; o <<= 1) s2 += __shfl_xor(s2, o);
    const float rstd = 1.0f / sqrtf(s2 * (1.0f / DM) + LN_EPS);
#pragma unroll
    for (int j = 0; j < 4; ++j) { const f32x4 gg = ((const f32x4*)g)[lane + 64 * j], bb = ((const f32x4*)bta)[lane + 64 * j]; p[64 * j] = v[j] * rstd * gg + bb; }
  }
}

constexpr int LDS_BYTES = 147456;
struct Params { const float* in[14]; float* out; unsigned char* ws; };
__global__ void __launch_bounds__(512, 2) fwd_megakernel(Params p) {
    cg::grid_group grid = cg::this_grid();
    extern __shared__ __attribute__((aligned(16))) unsigned char lds[];
    PG8_LAS unsigned char* ldsp = (PG8_LAS unsigned char*)lds;
    const float* x = p.in[0]; const float* w_in = p.in[1]; const float* b_in = p.in[2];
    const float* conv_w = p.in[3]; const float* conv_b = p.in[4]; const float* cln_g = p.in[5]; const float* cln_b = p.in[6];
    const float* w_co = p.in[7]; const float* relb = p.in[8]; const float* w_ao = p.in[9];
    const float* w_o = p.in[10]; const float* b_o = p.in[11]; const float* oln_g = p.in[12]; const float* oln_b = p.in[13];
    unsigned char* ws = p.ws; float* out = p.out;
    bf16_t* Win_t = (bf16_t*)(ws + WS_WIN); bf16_t* Wc_t = (bf16_t*)(ws + WS_WC); bf16_t* Wa_t = (bf16_t*)(ws + WS_WA); bf16_t* Wo_t = (bf16_t*)(ws + WS_WO);
    bf16_t* xb = (bf16_t*)(ws + WS_XB); bf16_t* hb = (bf16_t*)(ws + WS_H); bf16_t* z = (bf16_t*)(ws + WS_Z); bf16_t* uc = (bf16_t*)(ws + WS_UC); bf16_t* og = (bf16_t*)(ws + WS_OG);
    const int G = (int)gridDim.x, bid = (int)blockIdx.x;
    p_cvt(x, xb, (size_t)M * DM / 8);
    p_transpose(w_in, Win_t, DM, DIN); p_transpose(w_co, Wc_t, DC, DM); p_transpose(w_ao, Wa_t, DA, DM); p_transpose(w_o, Wo_t, DM, DM);
    grid.sync();
    { pg8::Gemm g{xb, Win_t, M, DIN, DM}; pg8::StaticOrder S; S.init(M, DIN, G, bid);
      pg8::EpiBf16<0> E{z, DIN, b_in, 0, 0, 1.f};
      pg8::gemm_phase<pg8::EpiBf16<0>, pg8::StaticOrder, PG8_ALIGN, PG8_SP2>(ldsp, g, S, E); }
    grid.sync();
    p_conv(z, conv_w, conv_b, cln_g, cln_b, uc, (float (*)[CT])lds);
    p_attn(z, relb, og);
    grid.sync();
    { pg8::Gemm g{uc, Wc_t, M, DM, DC}; pg8::StaticOrder S; S.init(M, DM, G, bid);
      pg8::EpiGate1 E{out, z, O_GC};
      pg8::gemm_phase<pg8::EpiGate1, pg8::StaticOrder, PG8_ALIGN, PG8_SP2>(ldsp, g, S, E); }
    { pg8::Gemm g{og, Wa_t, M, DM, DA}; pg8::StaticOrder S; S.init(M, DM, G, bid);
      pg8::EpiGate2 E{out, z, O_GA, hb};
      pg8::gemm_phase<pg8::EpiGate2, pg8::StaticOrder, PG8_ALIGN, PG8_SP2>(ldsp, g, S, E); }
    grid.sync();
    { pg8::Gemm g{hb, Wo_t, M, DM, DM}; pg8::StaticOrder S; S.init(M, DM, G, bid);
      pg8::EpiRes E{out, x, b_o};
      pg8::gemm_phase<pg8::EpiRes, pg8::StaticOrder, PG8_ALIGN, PG8_SP2>(ldsp, g, S, E); }
    grid.sync();
    p_ln(out, oln_g, oln_b);
}

extern "C" void kernel_launch(void* const* d_in, const int* in_sizes, int n_in, void* d_out, int out_size, void* d_ws, size_t ws_size, hipStream_t stream) {
    if (n_in != 14 || in_sizes[0] != M * DM || out_size != M * DM || ws_size < WS_END) { fprintf(stderr, "kernel_launch: unexpected shapes / workspace (n_in %d, ws %zu)\n", n_in, ws_size); return; }
    static int grid_blocks = 0;
    if (!grid_blocks) {
        int dev = 0, cus = 0, per_cu = 0;
        (void)hipGetDevice(&dev);
        (void)hipDeviceGetAttribute(&cus, hipDeviceAttributeMultiprocessorCount, dev);
        if (hipFuncSetAttribute((const void*)fwd_megakernel, hipFuncAttributeMaxDynamicSharedMemorySize, LDS_BYTES) != hipSuccess) fprintf(stderr, "kernel_launch: hipFuncSetAttribute failed\n");
        (void)hipOccupancyMaxActiveBlocksPerMultiprocessor(&per_cu, fwd_megakernel, 512, LDS_BYTES);
        if (per_cu < 1) { fprintf(stderr, "kernel_launch: occupancy query returned %d\n", per_cu); }
        grid_blocks = cus;
    }
    Params p{};
    for (int i = 0; i < 14; ++i) p.in[i] = (const float*)d_in[i];
    p.out = (float*)d_out; p.ws = (unsigned char*)d_ws;
    void* args[] = {&p};
    hipError_t e = hipLaunchCooperativeKernel((void*)fwd_megakernel, dim3(grid_blocks), dim3(512), args, LDS_BYTES, stream);
    if (e != hipSuccess) fprintf(stderr, "cooperative launch failed: %s (grid %d)\n", hipGetErrorString(e), grid_blocks);
}
```

```cpp
#include <hip/hip_runtime.h>
#include <hip/hip_cooperative_groups.h>
namespace cg = cooperative_groups;
#include <cstdio>
#include <cstdint>

typedef unsigned short bf16_t;
typedef short bf16x8 __attribute__((ext_vector_type(8)));
typedef float f32x4 __attribute__((ext_vector_type(4)));
typedef unsigned u32x4 __attribute__((ext_vector_type(4)));

constexpr int BATCH = 8, SEQ = 4096, DM = 1024, M = BATCH * SEQ;
constexpr int DC = 512, DA = 512, NH = 8, HD = 64, CW = 31, DIN = 5632, CHUNK = 64, NCH = SEQ / CHUNK, LEFT = 8;
constexpr int MAX_REL = 128, N_REL = 257;
constexpr int O_CVAL = 0, O_CGLU = 512, O_CGATE = 1024, O_Q = 1536, O_K = 2048, O_V = 2560, O_AG = 3072, O_GC = 3584, O_GA = 4608;
constexpr float LN_EPS = 1e-5f;
constexpr float ALPHA = 1.189207115002721f;

constexpr size_t MiB = 1u << 20;
constexpr size_t WS_WIN = 2 * MiB, WS_WC = 14 * MiB, WS_WA = 15 * MiB, WS_WO = 16 * MiB;
constexpr size_t WS_XB = 32 * MiB;
constexpr size_t WS_H = 32 * MiB;
constexpr size_t WS_Z = 96 * MiB;
constexpr size_t WS_UC = 448 * MiB;
constexpr size_t WS_OG = 480 * MiB;
constexpr size_t WS_END = 512 * MiB;

__device__ __forceinline__ unsigned f2bf(float f) { unsigned u = __builtin_bit_cast(unsigned, f); return (u + 0x7fffu + ((u >> 16) & 1u)) >> 16; }
__device__ __forceinline__ unsigned pk2(float lo, float hi) { return f2bf(lo) | (f2bf(hi) << 16); }
__device__ __forceinline__ float bf2f(bf16_t b) { return __uint_as_float(((unsigned)b) << 16); }
__device__ __forceinline__ float bflo(unsigned w) { return __uint_as_float(w << 16); }
__device__ __forceinline__ float bfhi(unsigned w) { return __uint_as_float(w & 0xffff0000u); }
__device__ __forceinline__ float sigmoidf_(float x) { return 1.0f / (1.0f + __expf(-x)); }
__device__ __forceinline__ float siluf_(float x) { return x / (1.0f + __expf(-x)); }

__device__ __forceinline__ int opaque_tid() { int t = (int)threadIdx.x; asm volatile("" : "+v"(t)); return t; }
__device__ __forceinline__ void p_cvt(const float* __restrict__ x, bf16_t* __restrict__ xb, size_t n8) {
    for (size_t i = (size_t)blockIdx.x * blockDim.x + opaque_tid(); i < n8; i += (size_t)gridDim.x * blockDim.x) {
        const f32x4 a = ((const f32x4*)x)[2 * i], b = ((const f32x4*)x)[2 * i + 1];
        u32x4 o; o.x = pk2(a.x, a.y); o.y = pk2(a.z, a.w); o.z = pk2(b.x, b.y); o.w = pk2(b.z, b.w);
        ((u32x4*)xb)[i] = o;
    }
}
__device__ __forceinline__ void p_transpose(const float* __restrict__ W, bf16_t* __restrict__ Wt, int K, int N) {
    const size_t total = (size_t)K * N;
    for (size_t i = (size_t)blockIdx.x * blockDim.x + opaque_tid(); i < total; i += (size_t)gridDim.x * blockDim.x) {
        const int n = (int)(i / K), k = (int)(i % K);
        Wt[i] = (bf16_t)f2bf(W[(size_t)k * N + n]);
    }
}

namespace pg8 {
#define PG8_LAS __attribute__((address_space(3)))
typedef unsigned short bf16_t;
typedef short bf16x8 __attribute__((ext_vector_type(8)));
typedef float f32x4 __attribute__((ext_vector_type(4)));
typedef unsigned u32x4 __attribute__((ext_vector_type(4)));
constexpr int BM = 256, BK = 64, HALF = 128, HTB = HALF * BK * 2  , STAGE_BYTES = 8 * HTB, NXCD = 8, WGM = 8;

__host__ __device__ __forceinline__ int lds_byte(int r, int c) { const int st = (r >> 4) * 2 + (c >> 5), rr = r & 15, cc = c & 31, ob = rr * 64 + cc * 2; return st * 1024 + (ob ^ (((ob >> 9) & 1) << 5)); }
__host__ __device__ __forceinline__ void stage_rc(int b, int& R, int& C) { const int st = b / 1024, sb = b % 1024, swz = sb ^ (((sb >> 9) & 1) << 5); R = (st >> 1) * 16 + swz / 64; C = (st & 1) * 32 + (swz % 64) / 2; }
__host__ __device__ __forceinline__ int perm32(int rho) { const int n = rho >> 4, i = rho & 15; return 8 * (i >> 2) + 4 * n + (i & 3); }

struct Unit { int pm, pn; };
struct Gemm { const bf16_t* A; const bf16_t* Bt; int M, N, K; };

struct StaticOrder {
    int nM, nN, nwg, G, c;
    __host__ __device__ void init(int M, int N, int G_, int c_) { nM = M / BM; nN = N / BM; nwg = nM * nN; G = G_; c = c_; }
    __host__ __device__ bool next(int i, Unit& u) const {
        const long L = (long)i * G + c; if (L >= nwg) return false;
        int wgid = (int)L; { const int q = nwg / NXCD, r = nwg % NXCD, xcd = wgid % NXCD, off = wgid / NXCD; wgid = (xcd < r ? xcd * (q + 1) : r * (q + 1) + (xcd - r) * q) + off; }
        const int nig = WGM * nN, gid = wgid / nig, fm = gid * WGM, gsz = (nM - fm) < WGM ? (nM - fm) : WGM;
        u.pm = fm + ((wgid % nig) % gsz); u.pn = (wgid % nig) / gsz; return true;
    }
    __device__ __forceinline__ void a_ready(const Unit&) const {}
    __device__ __forceinline__ void done(const Unit&) const {}
};

__device__ __forceinline__ unsigned cvt_pk_bf16(float lo, float hi) { unsigned r; asm volatile("v_cvt_pk_bf16_f32 %0, %1, %2" : "=v"(r) : "v"(lo), "v"(hi)); return r; }
typedef float f32x2 __attribute__((ext_vector_type(2)));
__device__ __forceinline__ f32x2 gelu_pk(f32x2 v) {
    const f32x2 av = __builtin_elementwise_abs(v), d = av * 0.2316418882f + 1.0f;
    f32x2 t; t.x = __builtin_amdgcn_rcpf(d.x); t.y = __builtin_amdgcn_rcpf(d.y);
    f32x2 q = t * 0.5307027145f + (-0.7265760135f); q = q * t + 0.7107068705f; q = q * t + (-0.142248368f); q = q * t + 0.127414796f; q = q * t;
    const f32x2 s = (v * v) * (-0.72134752044f);
    f32x2 e; e.x = __builtin_amdgcn_exp2f(s.x); e.y = __builtin_amdgcn_exp2f(s.y);
    const f32x2 m = v * (q * e), r = v - m;
    f32x2 o; o.x = v.x < 0.f ? m.x : r.x; o.y = v.y < 0.f ? m.y : r.y; return o;
}

template <int ACT  > struct EpiBf16 {
    static constexpr bool PERM = true, AFTER_DRAIN = false; static_assert(ACT == 0 || ACT == 1, "EpiBf16: ACT is 0 (none) or 1 (gelu_pk)");
    bf16_t* O; int ldc; const float* bias; int split_cols; size_t split_stride; float scale0;
    __device__ __forceinline__ void operator()(const f32x4 (&acc)[2][2][4][2], const Unit& u, int wr, int wc, int fr, int fq) const {
        const int row0 = u.pm * BM + wr * 64 + fr; int colt = u.pn * BM; bf16_t* base = O;
        float sc = 1.f; if (split_cols) { const int t = colt / split_cols; base += (size_t)t * split_stride; colt -= t * split_cols; if (t == 0) sc = scale0; }
        const int col0 = colt + wc * 32 + 8 * fq, bcol0 = u.pn * BM + wc * 32 + 8 * fq;
        f32x4 bv[2][2];
#pragma unroll
        for (int bj = 0; bj < 2; ++bj)
#pragma unroll
            for (int n = 0; n < 2; ++n) bv[bj][n] = bias ? *(const f32x4*)(bias + bcol0 + bj * HALF + 4 * n) : (f32x4){0.f, 0.f, 0.f, 0.f};
#pragma unroll
        for (int ai = 0; ai < 2; ++ai)
#pragma unroll
            for (int m = 0; m < 4; ++m) { bf16_t* rowp = base + (size_t)(row0 + ai * HALF + m * 16) * ldc + col0;
#pragma unroll
                for (int bj = 0; bj < 2; ++bj) { f32x4 v0 = acc[ai][bj][m][0] + bv[bj][0], v1 = acc[ai][bj][m][1] + bv[bj][1];
                    if (ACT == 1) { f32x2 a = gelu_pk((f32x2){v0[0], v0[1]}), b = gelu_pk((f32x2){v0[2], v0[3]}), c = gelu_pk((f32x2){v1[0], v1[1]}), d = gelu_pk((f32x2){v1[2], v1[3]});
                        v0 = (f32x4){a.x, a.y, b.x, b.y}; v1 = (f32x4){c.x, c.y, d.x, d.y}; }
                    v0 = v0 * sc; v1 = v1 * sc; u32x4 w; w.x = cvt_pk_bf16(v0[0], v0[1]); w.y = cvt_pk_bf16(v0[2], v0[3]); w.z = cvt_pk_bf16(v1[0], v1[1]); w.w = cvt_pk_bf16(v1[2], v1[3]);
                    *(u32x4*)(rowp + bj * HALF) = w; } }
    }
};

struct PanelStats {
    unsigned* xbuf;
    unsigned* cnt;
    unsigned* tmo;
    int ntn; float eps;
    unsigned code;
    __device__ __forceinline__ bool run(const f32x4 (&v)[2][2][4][2], const Unit& u, int wr, int wc, int fr, int fq, PG8_LAS unsigned char* lds, int wid, int lane) const {
        typedef float f32x2v __attribute__((ext_vector_type(2)));
        PG8_LAS f32x2v* P = (PG8_LAS f32x2v*)lds;
        PG8_LAS f32x2v* S = (PG8_LAS f32x2v*)(lds + 8192);
        PG8_LAS unsigned* flag = (PG8_LAS unsigned*)(lds + 8192 + 2048);
#pragma unroll
        for (int ai = 0; ai < 2; ++ai)
#pragma unroll
            for (int m = 0; m < 4; ++m) {
                float s = 0.f;
#pragma unroll
                for (int bj = 0; bj < 2; ++bj)
#pragma unroll
                    for (int n = 0; n < 2; ++n) { const f32x4 x = v[ai][bj][m][n]; s += (x[0] + x[1]) + (x[2] + x[3]); }
                s += __shfl_xor(s, 16); s += __shfl_xor(s, 32);
                const float mw = s * (1.0f / 64.0f); float q = 0.f;
#pragma unroll
                for (int bj = 0; bj < 2; ++bj)
#pragma unroll
                    for (int n = 0; n < 2; ++n) { const f32x4 d = v[ai][bj][m][n] - mw; q += (d[0] * d[0] + d[1] * d[1]) + (d[2] * d[2] + d[3] * d[3]); }
                q += __shfl_xor(q, 16); q += __shfl_xor(q, 32);
                if (fq == 0) P[(ai * HALF + wr * 64 + m * 16 + fr) * 4 + wc] = (f32x2v){mw, q};
            }
        asm volatile("s_waitcnt lgkmcnt(0)" ::: "memory"); __builtin_amdgcn_s_barrier(); asm volatile("" ::: "memory");
#if defined(BROKEN_EXCHANGE_NO_WAIT)
#warning BROKEN CONTROL BUILD: the row-statistics exchange does not wait; results are wrong by design
        if (blockIdx.x >= 64) { const long long t0_ = clock64(); while (clock64() - t0_ < 60000) __builtin_amdgcn_s_sleep(8); }
#endif
        const int row = wid * 32 + (lane & 31);
        if (lane < 32) {
            const f32x2v a = P[row * 4 + 0], b = P[row * 4 + 1], c = P[row * 4 + 2], d = P[row * 4 + 3];
            const float mt = (a.x + b.x + c.x + d.x) * 0.25f;
            const float da = a.x - mt, db = b.x - mt, dc = c.x - mt, dd = d.x - mt;
            const float m2 = (a.y + b.y) + (c.y + d.y) + 64.0f * ((da * da + db * db) + (dc * dc + dd * dd));
            unsigned long long* slot = (unsigned long long*)xbuf + ((size_t)(u.pm * BM + row) * 4 + u.pn);
            __hip_atomic_store(slot, ((unsigned long long)__float_as_uint(m2) << 32) | __float_as_uint(mt), __ATOMIC_RELAXED, __HIP_MEMORY_SCOPE_AGENT);
        }
        asm volatile("s_waitcnt vmcnt(0)" ::: "memory");
        if (lane == 0) __hip_atomic_fetch_add(cnt + 64 * u.pm, 1u, __ATOMIC_RELAXED, __HIP_MEMORY_SCOPE_AGENT);
        if (wid == 0) {
            bool dead = false; const unsigned long long t0 = __builtin_amdgcn_s_memrealtime(); const unsigned want = 8u * (unsigned)ntn;
            for (;;) {
#if defined(BROKEN_EXCHANGE_NO_WAIT)
                break;
#endif
                if ((unsigned)__builtin_amdgcn_readfirstlane(__hip_atomic_load(cnt + 64 * u.pm, __ATOMIC_RELAXED, __HIP_MEMORY_SCOPE_AGENT)) >= want) break;
                if (__builtin_amdgcn_s_memrealtime() - t0 > 2000000ull) {
                    if (lane == 0) { unsigned expect = 0u; __hip_atomic_compare_exchange_strong(tmo + 1, &expect, code | (unsigned)(u.pm & 0xff), __ATOMIC_RELAXED, __ATOMIC_RELAXED, __HIP_MEMORY_SCOPE_AGENT);
                                     __hip_atomic_store(tmo, 1u, __ATOMIC_RELAXED, __HIP_MEMORY_SCOPE_AGENT); }
                    dead = true; break; }
                __builtin_amdgcn_s_sleep(2);
            }
            __builtin_amdgcn_fence(__ATOMIC_ACQUIRE, "agent");
            if (lane == 0) flag[0] = dead ? 1u : 0u;
        }
        asm volatile("s_waitcnt vmcnt(0) lgkmcnt(0)" ::: "memory"); __builtin_amdgcn_s_barrier(); asm volatile("" ::: "memory");
        const bool bad = flag[0] != 0u;
        if (lane < 32) {
            const unsigned long long* slot = (const unsigned long long*)xbuf + (size_t)(u.pm * BM + row) * 4; float mt[4], m2[4]; float ms = 0.f;
#pragma unroll
            for (int t = 0; t < 4; ++t) { if (t < ntn) { const unsigned long long w = __hip_atomic_load(slot + t, __ATOMIC_RELAXED, __HIP_MEMORY_SCOPE_AGENT); mt[t] = __uint_as_float((unsigned)w); m2[t] = __uint_as_float((unsigned)(w >> 32)); } else { mt[t] = 0.f; m2[t] = 0.f; } ms += mt[t]; }
            const float mean = ms / (float)ntn; float q = 0.f;
#pragma unroll
            for (int t = 0; t < 4; ++t) if (t < ntn) { const float dm = mt[t] - mean; q += m2[t] + 256.0f * dm * dm; }
            S[row] = (f32x2v){mean, 1.0f / sqrtf(q / (256.0f * (float)ntn) + eps)};
        }
        asm volatile("s_waitcnt lgkmcnt(0)" ::: "memory"); __builtin_amdgcn_s_barrier(); asm volatile("" ::: "memory");
        return bad;
    }
};
struct EpiLnRes {
    static constexpr bool PERM = false, AFTER_DRAIN = true;
    const float* base; float* out; int ldc; const float* bias; PanelStats st; unsigned poison;
    __device__ __forceinline__ void fused(f32x4 (&acc)[2][2][4][2], const Unit& u, int wr, int wc, int fr, int fq, PG8_LAS unsigned char* lds, int wid, int lane) const {
        typedef float f32x2v __attribute__((ext_vector_type(2)));
        const PG8_LAS f32x2v* S = (const PG8_LAS f32x2v*)(lds + 8192);
        const int col0 = u.pn * BM + wc * 32 + 4 * fq;
#pragma unroll
        for (int bj = 0; bj < 2; ++bj)
#pragma unroll
            for (int n = 0; n < 2; ++n) { const f32x4 bv = bias ? *(const f32x4*)(bias + col0 + bj * HALF + n * 16) : (f32x4){0.f, 0.f, 0.f, 0.f};
#pragma unroll
                for (int ai = 0; ai < 2; ++ai)
#pragma unroll
                    for (int m = 0; m < 4; ++m) acc[ai][bj][m][n] += bv; }
        f32x4 pre[4][2][2];
#pragma unroll
        for (int m = 0; m < 4; ++m) { const size_t off = (size_t)(u.pm * BM + wr * 64 + m * 16 + fr) * ldc + col0;
#pragma unroll
            for (int bj = 0; bj < 2; ++bj)
#pragma unroll
                for (int n = 0; n < 2; ++n) pre[m][bj][n] = *(const f32x4*)(base + off + bj * HALF + n * 16); }
        const bool bad = st.run(acc, u, wr, wc, fr, fq, lds, wid, lane) || poison != 0u;
        const float qnan = __builtin_nanf("");
#pragma unroll
        for (int ai = 0; ai < 2; ++ai)
#pragma unroll
            for (int m = 0; m < 4; ++m) { const int r = ai * HALF + wr * 64 + m * 16 + fr; const f32x2v sr = S[r]; const size_t off = (size_t)(u.pm * BM + r) * ldc + col0;
#pragma unroll
                for (int bj = 0; bj < 2; ++bj)
#pragma unroll
                    for (int n = 0; n < 2; ++n) { const f32x4 bs = ai == 0 ? pre[m][bj][n] : *(const f32x4*)(base + off + bj * HALF + n * 16); f32x4 o = bs + (acc[ai][bj][m][n] - sr.x) * sr.y;
                        if (bad) o = (f32x4){qnan, qnan, qnan, qnan}; *(f32x4*)(out + off + bj * HALF + n * 16) = o; }
                if (m & 1) asm volatile("" ::: "memory"); }
    }
};
struct EpiLnResLn {
    static constexpr bool PERM = false, AFTER_DRAIN = true;
    const float* base; float* out; bf16_t* xn; int ldc; const float* bias; PanelStats st1, st2; unsigned poison;
    __device__ __forceinline__ void fused(f32x4 (&acc)[2][2][4][2], const Unit& u, int wr, int wc, int fr, int fq, PG8_LAS unsigned char* lds, int wid, int lane) const {
        typedef float f32x2v __attribute__((ext_vector_type(2))); typedef unsigned u32x2v __attribute__((ext_vector_type(2)));
        const PG8_LAS f32x2v* S = (const PG8_LAS f32x2v*)(lds + 8192);
        const int col0 = u.pn * BM + wc * 32 + 4 * fq;
#pragma unroll
        for (int bj = 0; bj < 2; ++bj)
#pragma unroll
            for (int n = 0; n < 2; ++n) { const f32x4 bv = bias ? *(const f32x4*)(bias + col0 + bj * HALF + n * 16) : (f32x4){0.f, 0.f, 0.f, 0.f};
#pragma unroll
                for (int ai = 0; ai < 2; ++ai)
#pragma unroll
                    for (int m = 0; m < 4; ++m) acc[ai][bj][m][n] += bv; }
        bool bad = st1.run(acc, u, wr, wc, fr, fq, lds, wid, lane) || poison != 0u;
        const float qnan = __builtin_nanf("");
#pragma unroll
        for (int ai = 0; ai < 2; ++ai)
#pragma unroll
            for (int m = 0; m < 4; ++m) { const int r = ai * HALF + wr * 64 + m * 16 + fr; const f32x2v sr = S[r]; const size_t off = (size_t)(u.pm * BM + r) * ldc + col0;
#pragma unroll
                for (int bj = 0; bj < 2; ++bj)
#pragma unroll
                    for (int n = 0; n < 2; ++n) { const f32x4 bs = *(const f32x4*)(base + off + bj * HALF + n * 16); acc[ai][bj][m][n] = bs + (acc[ai][bj][m][n] - sr.x) * sr.y; }
                asm volatile("" : "+v"(acc[ai][0][m][0]), "+v"(acc[ai][0][m][1]), "+v"(acc[ai][1][m][0]), "+v"(acc[ai][1][m][1]));
                if (m & 1) asm volatile("" ::: "memory"); }
        const bool bad1 = bad;
        bad = st2.run(acc, u, wr, wc, fr, fq, lds, wid, lane) || bad;
#pragma unroll
        for (int ai = 0; ai < 2; ++ai)
#pragma unroll
            for (int m = 0; m < 4; ++m) { const int r = ai * HALF + wr * 64 + m * 16 + fr; const f32x2v sr = S[r]; const size_t off = (size_t)(u.pm * BM + r) * ldc + col0;
#pragma unroll
                for (int bj = 0; bj < 2; ++bj)
#pragma unroll
                    for (int n = 0; n < 2; ++n) { const f32x4 x1 = acc[ai][bj][m][n]; *(f32x4*)(out + off + bj * HALF + n * 16) = bad1 ? (f32x4){qnan, qnan, qnan, qnan} : x1;
                        const f32x4 o = (x1 - sr.x) * sr.y; u32x2v w; w.x = cvt_pk_bf16(o[0], o[1]); w.y = cvt_pk_bf16(o[2], o[3]);
                        if (bad) { w.x = 0x7fc07fc0u; w.y = 0x7fc07fc0u; } *(u32x2v*)(xn + off + bj * HALF + n * 16) = w; }
                asm volatile("" ::: "memory"); }
    }
};

template <class Epi, class Sched, bool ALIGN_EPI = false, bool SP2 = false>
__device__ __forceinline__ void gemm_phase(PG8_LAS unsigned char* lds, const Gemm g, const Sched& S, const Epi& E) {
    const int tid = opaque_tid(), wid = __builtin_amdgcn_readfirstlane(tid >> 6), lane = tid & 63, wr = wid >> 2, wc = wid & 3, fr = lane & 15, fq = lane >> 4;
    const int K = g.K, nt = K / BK;
    unsigned voffA[2], voffB[2];
#pragma unroll
    for (int i = 0; i < 2; ++i) { int R, C; stage_rc(tid * 16 + i * 8192, R, C); const int Rb = Epi::PERM ? ((R & ~31) + perm32(R & 31)) : R;
        voffA[i] = (unsigned)(R * K + C) * 2u; voffB[i] = (unsigned)(Rb * K + C) * 2u; }
    const size_t kstep = (size_t)(BK * 2);
    const size_t hstep = (size_t)HALF * K * 2;
    const size_t tstep = 2 * hstep;
    const unsigned ldsw = (unsigned)wid * 1024u;
    const int aoff = lds_byte(wr * 64 + fr, fq * 8), boff = lds_byte(wc * 32 + fr, fq * 8);
#define PG8_SA(b, h) (((b) * 2 + (h)) * HTB)
#define PG8_SB(b, h) ((4 + (b) * 2 + (h)) * HTB)
#define PG8_STAGE(bufoff, gbase, voff) do { _Pragma("unroll") for (int _i = 0; _i < 2; ++_i) \
        __builtin_amdgcn_global_load_lds((const unsigned*)((const char*)(gbase) + (voff)[_i]), (PG8_LAS unsigned*)(lds + (bufoff) + ldsw + _i * 8192), 16, 0, 0); } while (0)
#define PG8_LDA(dst, b, h) do { _Pragma("unroll") for (int m = 0; m < 4; ++m) _Pragma("unroll") for (int k = 0; k < 2; ++k) dst[m][k] = *(const PG8_LAS bf16x8*)(lds + PG8_SA(b, h) + aoff + m * 2048 + k * 1024); } while (0)
#define PG8_LDB(dst, b, h) do { _Pragma("unroll") for (int n = 0; n < 2; ++n) _Pragma("unroll") for (int k = 0; k < 2; ++k) dst[n][k] = *(const PG8_LAS bf16x8*)(lds + PG8_SB(b, h) + boff + n * 2048 + k * 1024); } while (0)
#define PG8_MMA(ai, bj, At, Bt) do { __builtin_amdgcn_s_setprio(1); _Pragma("unroll") for (int m = 0; m < 4; ++m) _Pragma("unroll") for (int n = 0; n < 2; ++n) _Pragma("unroll") for (int k = 0; k < 2; ++k) \
        acc[ai][bj][m][n] = __builtin_amdgcn_mfma_f32_16x16x32_bf16(Bt[n][k], At[m][k], acc[ai][bj][m][n], 0, 0, 0); __builtin_amdgcn_s_setprio(0); } while (0)
#define PG8_WAIT_V(n) asm volatile("s_waitcnt vmcnt(" #n ")" ::: "memory")
#define PG8_WAIT_L(n) asm volatile("s_waitcnt lgkmcnt(" #n ")" ::: "memory")
#define PG8_BAR __builtin_amdgcn_s_barrier()
#define PG8_SCHED __builtin_amdgcn_sched_barrier(0)
    Unit cur, nxt; int ui = 0;
    if (!S.next(0, cur)) return;
    f32x4 acc[2][2][4][2];
#pragma unroll
    for (int a = 0; a < 2; ++a)
#pragma unroll
        for (int b = 0; b < 2; ++b)
#pragma unroll
            for (int m = 0; m < 4; ++m)
#pragma unroll
                for (int n = 0; n < 2; ++n) acc[a][b][m][n] = (f32x4){0.f, 0.f, 0.f, 0.f};
    bf16x8 At[4][2], B0[2][2], B1[2][2];
    const char* cA = (const char*)g.A + (size_t)cur.pm * tstep; const char* cB = (const char*)g.Bt + (size_t)cur.pn * tstep;
    S.a_ready(cur);
    if constexpr (SP2) {
        PG8_STAGE(PG8_SB(0, 0), cB, voffB); PG8_STAGE(PG8_SB(0, 1), cB + hstep, voffB); PG8_STAGE(PG8_SA(0, 0), cA, voffA); PG8_STAGE(PG8_SA(0, 1), cA + hstep, voffA);
        if (wr == 1) PG8_BAR;
        PG8_WAIT_V(2); PG8_BAR;
        PG8_STAGE(PG8_SB(1, 0), cB + kstep, voffB); PG8_STAGE(PG8_SA(1, 0), cA + kstep, voffA); PG8_STAGE(PG8_SB(1, 1), cB + hstep + kstep, voffB);
        PG8_WAIT_V(6); PG8_BAR;
    } else {
        PG8_STAGE(PG8_SB(0, 0), cB, voffB); PG8_STAGE(PG8_SA(0, 0), cA, voffA); PG8_STAGE(PG8_SB(0, 1), cB + hstep, voffB); PG8_STAGE(PG8_SA(0, 1), cA + hstep, voffA);
        if (wr == 1) PG8_BAR;
        PG8_WAIT_V(4); PG8_BAR;
        PG8_STAGE(PG8_SB(1, 0), cB + kstep, voffB); PG8_STAGE(PG8_SA(1, 0), cA + kstep, voffA); PG8_STAGE(PG8_SB(1, 1), cB + hstep + kstep, voffB);
        PG8_WAIT_V(6); PG8_BAR;
    }
    for (;;) {
        const bool has_next = S.next(ui + 1, nxt);
        const char* nA = has_next ? (const char*)g.A + (size_t)nxt.pm * tstep : cA; const char* nB = has_next ? (const char*)g.Bt + (size_t)nxt.pn * tstep : cB;
        for (int t = 0; t < nt; t += 2) {
            const bool last = (t == nt - 2);
            const char* a1 = cA + (size_t)(t + 1) * kstep;
            const char* a2 = last ? nA : cA + (size_t)(t + 2) * kstep; const char* b2 = last ? nB : cB + (size_t)(t + 2) * kstep;
            const char* a3 = a2 + kstep; const char* b3 = b2 + kstep;
            if (last && has_next) S.a_ready(nxt);
            if constexpr (SP2) {
            PG8_LDB(B0, 0, 0); PG8_LDB(B1, 0, 1); PG8_SCHED; PG8_LDA(At, 0, 0); PG8_STAGE(PG8_SA(1, 1), a1 + hstep, voffA);
            PG8_WAIT_V(8); PG8_WAIT_L(0); PG8_BAR; PG8_MMA(0, 0, At, B0); PG8_MMA(0, 1, At, B1); PG8_BAR; PG8_SCHED;
            PG8_LDA(At, 0, 1); PG8_STAGE(PG8_SB(0, 0), b2, voffB); PG8_STAGE(PG8_SB(0, 1), b2 + hstep, voffB); PG8_STAGE(PG8_SA(0, 0), a2, voffA);
            PG8_WAIT_V(8); PG8_WAIT_L(0); PG8_BAR; PG8_MMA(1, 0, At, B0); PG8_MMA(1, 1, At, B1); PG8_BAR; PG8_SCHED;
            PG8_LDB(B0, 1, 0); PG8_LDB(B1, 1, 1); PG8_SCHED; PG8_LDA(At, 1, 0); PG8_STAGE(PG8_SA(0, 1), a2 + hstep, voffA);
            PG8_WAIT_V(8); PG8_WAIT_L(0); PG8_BAR; PG8_MMA(0, 0, At, B0); PG8_MMA(0, 1, At, B1); PG8_BAR; PG8_SCHED;
            PG8_LDA(At, 1, 1); PG8_STAGE(PG8_SB(1, 0), b3, voffB); PG8_STAGE(PG8_SB(1, 1), b3 + hstep, voffB); PG8_STAGE(PG8_SA(1, 0), a3, voffA);
            PG8_WAIT_V(8); PG8_WAIT_L(0); PG8_BAR; PG8_MMA(1, 0, At, B0); PG8_MMA(1, 1, At, B1); PG8_BAR; PG8_SCHED;
            } else {
            PG8_LDB(B0, 0, 0); PG8_SCHED; PG8_LDA(At, 0, 0); PG8_STAGE(PG8_SA(1, 1), a1 + hstep, voffA);
            PG8_WAIT_L(8); PG8_BAR; PG8_WAIT_L(0); PG8_MMA(0, 0, At, B0); PG8_BAR; PG8_SCHED;
            PG8_LDB(B1, 0, 1); PG8_STAGE(PG8_SB(0, 0), b2, voffB);
            PG8_BAR; PG8_WAIT_L(0); PG8_MMA(0, 1, At, B1); PG8_BAR;
            PG8_LDA(At, 0, 1); PG8_STAGE(PG8_SA(0, 0), a2, voffA);
            PG8_BAR; PG8_WAIT_L(0); PG8_MMA(1, 0, At, B0); PG8_BAR; PG8_SCHED;
            PG8_STAGE(PG8_SB(0, 1), b2 + hstep, voffB);
            PG8_WAIT_V(6); PG8_BAR; PG8_MMA(1, 1, At, B1); PG8_BAR;
            PG8_LDB(B0, 1, 0); PG8_SCHED; PG8_LDA(At, 1, 0); PG8_STAGE(PG8_SA(0, 1), a2 + hstep, voffA);
            PG8_WAIT_L(8); PG8_BAR; PG8_WAIT_L(0); PG8_MMA(0, 0, At, B0); PG8_BAR; PG8_SCHED;
            PG8_LDB(B1, 1, 1); PG8_STAGE(PG8_SB(1, 0), b3, voffB);
            PG8_BAR; PG8_WAIT_L(0); PG8_MMA(0, 1, At, B1); PG8_BAR;
            PG8_LDA(At, 1, 1); PG8_STAGE(PG8_SA(1, 0), a3, voffA);
            PG8_BAR; PG8_WAIT_L(0); PG8_MMA(1, 0, At, B0); PG8_BAR; PG8_SCHED;
            PG8_STAGE(PG8_SB(1, 1), b3 + hstep, voffB);
            PG8_WAIT_V(6); PG8_BAR; PG8_MMA(1, 1, At, B1); PG8_BAR;
            }
        }
        if constexpr (ALIGN_EPI) { if (wr == 0) PG8_BAR; }
        if constexpr (!Epi::AFTER_DRAIN) { E(acc, cur, wr, wc, fr, fq); S.done(cur); }
        if (!has_next) break;
#pragma unroll
        for (int a = 0; a < 2; ++a)
#pragma unroll
            for (int b = 0; b < 2; ++b)
#pragma unroll
                for (int m = 0; m < 4; ++m)
#pragma unroll
                    for (int n = 0; n < 2; ++n) acc[a][b][m][n] = (f32x4){0.f, 0.f, 0.f, 0.f};
        cur = nxt; cA = nA; cB = nB; ++ui;
        if constexpr (ALIGN_EPI) { if (wr == 1) PG8_BAR; }
    }
    PG8_WAIT_V(0);
    if constexpr (!ALIGN_EPI) { if (wr == 0) PG8_BAR; }
    PG8_BAR;
    if constexpr (Epi::AFTER_DRAIN) { E.fused(acc, cur, wr, wc, fr, fq, lds, wid, lane); S.done(cur); }
#undef PG8_SA
#undef PG8_SB
#undef PG8_STAGE
#undef PG8_LDA
#undef PG8_LDB
#undef PG8_MMA
#undef PG8_WAIT_V
#undef PG8_WAIT_L
#undef PG8_BAR
#undef PG8_SCHED
}
}

#ifndef PG8_SP2
#define PG8_SP2 true
#endif
#ifndef PG8_ALIGN
#define PG8_ALIGN true
#endif

namespace pg8 {
__device__ __forceinline__ float sigm(float x) { return __builtin_amdgcn_rcpf(1.0f + __expf(-x)); }
struct EpiGate1 {
    static constexpr bool PERM = true, AFTER_DRAIN = false;
    float* T; const bf16_t* z; int gcol;
    __device__ __forceinline__ void operator()(const f32x4 (&acc)[2][2][4][2], const Unit& u, int wr, int wc, int fr, int fq) const {
        const int row0 = u.pm * BM + wr * 64 + fr, col0 = u.pn * BM + wc * 32 + 8 * fq;
#pragma unroll
        for (int ai = 0; ai < 2; ++ai)
#pragma unroll
            for (int m = 0; m < 4; ++m) { const size_t r = (size_t)(row0 + ai * HALF + m * 16);
#pragma unroll
                for (int bj = 0; bj < 2; ++bj) { const int c = col0 + bj * HALF;
                    const u32x4 g = *(const u32x4*)(z + r * DIN + gcol + c);
                    const f32x4 s0 = {sigm(bflo(g.x)), sigm(bfhi(g.x)), sigm(bflo(g.y)), sigm(bfhi(g.y))}, s1 = {sigm(bflo(g.z)), sigm(bfhi(g.z)), sigm(bflo(g.w)), sigm(bfhi(g.w))};
                    *(f32x4*)(T + r * DM + c) = acc[ai][bj][m][0] * s0; *(f32x4*)(T + r * DM + c + 4) = acc[ai][bj][m][1] * s1; } }
    }
};
struct EpiGate2 {
    static constexpr bool PERM = true, AFTER_DRAIN = false;
    const float* T; const bf16_t* z; int gcol; bf16_t* H;
    __device__ __forceinline__ void operator()(const f32x4 (&acc)[2][2][4][2], const Unit& u, int wr, int wc, int fr, int fq) const {
        const int row0 = u.pm * BM + wr * 64 + fr, col0 = u.pn * BM + wc * 32 + 8 * fq;
#pragma unroll
        for (int ai = 0; ai < 2; ++ai)
#pragma unroll
            for (int m = 0; m < 4; ++m) { const size_t r = (size_t)(row0 + ai * HALF + m * 16);
#pragma unroll
                for (int bj = 0; bj < 2; ++bj) { const int c = col0 + bj * HALF;
                    const u32x4 g = *(const u32x4*)(z + r * DIN + gcol + c);
                    const f32x4 s0 = {sigm(bflo(g.x)), sigm(bfhi(g.x)), sigm(bflo(g.y)), sigm(bfhi(g.y))}, s1 = {sigm(bflo(g.z)), sigm(bfhi(g.z)), sigm(bflo(g.w)), sigm(bfhi(g.w))};
                    const f32x4 v0 = *(const f32x4*)(T + r * DM + c) + acc[ai][bj][m][0] * s0, v1 = *(const f32x4*)(T + r * DM + c + 4) + acc[ai][bj][m][1] * s1;
                    u32x4 w; w.x = cvt_pk_bf16(v0[0], v0[1]); w.y = cvt_pk_bf16(v0[2], v0[3]); w.z = cvt_pk_bf16(v1[0], v1[1]); w.w = cvt_pk_bf16(v1[2], v1[3]);
                    *(u32x4*)(H + r * DM + c) = w; } }
    }
};
struct EpiRes {
    static constexpr bool PERM = false, AFTER_DRAIN = false;
    float* C; const float* X; const float* bias;
    __device__ __forceinline__ void operator()(const f32x4 (&acc)[2][2][4][2], const Unit& u, int wr, int wc, int fr, int fq) const {
        const int row0 = u.pm * BM + wr * 64 + fr, col0 = u.pn * BM + wc * 32 + 4 * fq;
        f32x4 bv[2][2];
#pragma unroll
        for (int bj = 0; bj < 2; ++bj)
#pragma unroll
            for (int n = 0; n < 2; ++n) bv[bj][n] = *(const f32x4*)(bias + col0 + bj * HALF + n * 16);
#pragma unroll
        for (int ai = 0; ai < 2; ++ai)
#pragma unroll
            for (int m = 0; m < 4; ++m) { const size_t off = (size_t)(row0 + ai * HALF + m * 16) * DM + col0;
#pragma unroll
                for (int bj = 0; bj < 2; ++bj)
#pragma unroll
                    for (int n = 0; n < 2; ++n) *(f32x4*)(C + off + bj * HALF + n * 16) = *(const f32x4*)(X + off + bj * HALF + n * 16) * ALPHA + acc[ai][bj][m][n] + bv[bj][n]; }
    }
};
struct EpiVT {
    static constexpr bool PERM = true, AFTER_DRAIN = false;
    bf16_t* O; int ldc; const float* rbias;
    __device__ __forceinline__ void operator()(const f32x4 (&acc)[2][2][4][2], const Unit& u, int wr, int wc, int fr, int fq) const {
        const int row0 = u.pm * BM + wr * 64 + fr, col0 = u.pn * BM + wc * 32 + 8 * fq;
#pragma unroll
        for (int ai = 0; ai < 2; ++ai)
#pragma unroll
            for (int m = 0; m < 4; ++m) { const int r = row0 + ai * HALF + m * 16; const float bv = rbias[r]; bf16_t* rowp = O + (size_t)r * ldc + col0;
#pragma unroll
                for (int bj = 0; bj < 2; ++bj) { const f32x4 v0 = acc[ai][bj][m][0] + bv, v1 = acc[ai][bj][m][1] + bv;
                    u32x4 w; w.x = cvt_pk_bf16(v0[0], v0[1]); w.y = cvt_pk_bf16(v0[2], v0[3]); w.z = cvt_pk_bf16(v1[0], v1[1]); w.w = cvt_pk_bf16(v1[2], v1[3]);
                    *(u32x4*)(rowp + bj * HALF) = w; } }
    }
};
}

constexpr int CT = 8;
__device__ __forceinline__ void p_conv(const bf16_t* __restrict__ z, const float* __restrict__ cw, const float* __restrict__ cb,
                                              const float* __restrict__ lng, const float* __restrict__ lnb, bf16_t* __restrict__ uc, float (*sm)[CT]) {
  for (int tile = blockIdx.x; tile < M / CT; tile += gridDim.x) {
    const int c = opaque_tid(), wave = c >> 6, lane = c & 63;
    const int t0 = tile * CT;
    const int s0 = t0 % SEQ;
    float w[CW];
#pragma unroll
    for (int j = 0; j < CW; ++j) w[j] = cw[j * DC + c];
    float acc[CT];
    const float bias = cb[c];
#pragma unroll
    for (int i = 0; i < CT; ++i) acc[i] = bias;
#pragma unroll
    for (int p = 0; p < CT + CW - 1; ++p) {
        const int sp = s0 - (CW - 1) + p;
        float g = 0.f;
        if (sp >= 0) { const size_t r = (size_t)(t0 - (CW - 1) + p); const float a = bf2f(z[r * DIN + O_CVAL + c]), b = bf2f(z[r * DIN + O_CGLU + c]); g = a * sigmoidf_(b); }
#pragma unroll
        for (int i = 0; i < CT; ++i) { const int j = p - i; if (j >= 0 && j < CW) acc[i] += w[j] * g; }
    }
    float red[CT];
#pragma unroll
    for (int i = 0; i < CT; ++i) { float v = acc[i];
#pragma unroll
        for (int o = 1; o < 64; o <<= 1) v += __shfl_xor(v, o);
        red[i] = v; }
    if (lane == 0) {
#pragma unroll
        for (int i = 0; i < CT; ++i) sm[wave][i] = red[i]; }
    __syncthreads();
    float mean[CT];
#pragma unroll
    for (int i = 0; i < CT; ++i) { float s = 0.f;
#pragma unroll
        for (int wv = 0; wv < 8; ++wv) s += sm[wv][i];
        mean[i] = s * (1.0f / DC); }
    __syncthreads();
#pragma unroll
    for (int i = 0; i < CT; ++i) { const float d = acc[i] - mean[i]; float v = d * d;
#pragma unroll
        for (int o = 1; o < 64; o <<= 1) v += __shfl_xor(v, o);
        red[i] = v; }
    if (lane == 0) {
#pragma unroll
        for (int i = 0; i < CT; ++i) sm[wave][i] = red[i]; }
    __syncthreads();
    const float g_ = lng[c], b_ = lnb[c];
#pragma unroll
    for (int i = 0; i < CT; ++i) { float s = 0.f;
#pragma unroll
        for (int wv = 0; wv < 8; ++wv) s += sm[wv][i];
        const float rstd = 1.0f / sqrtf(s * (1.0f / DC) + LN_EPS);
        const float y = (acc[i] - mean[i]) * rstd * g_ + b_;
        const float gate = bf2f(z[(size_t)(t0 + i) * DIN + O_CGATE + c]);
        uc[(size_t)(t0 + i) * DC + c] = (bf16_t)f2bf(siluf_(y) * siluf_(gate)); }
    __syncthreads();
  }
}

typedef float f32x16 __attribute__((ext_vector_type(16)));
typedef float f32x2_t __attribute__((ext_vector_type(2))); typedef __bf16 bf16x2_t __attribute__((ext_vector_type(2)));
__device__ __forceinline__ unsigned cvtpk_s(float lo, float hi) { f32x2_t v = {lo, hi}; bf16x2_t b = __builtin_convertvector(v, bf16x2_t); return __builtin_bit_cast(unsigned, b); }
constexpr int TABN = 320;
constexpr float LOG2E = 1.4426950408889634f;
constexpr float C1 = 0.125f * LOG2E;
template <int ZP> __device__ __forceinline__ void p_attn(const bf16_t* __restrict__ z, const int oq, const int ok, const int oag, const bf16_t* __restrict__ vt, const float* __restrict__ relb,
                                                        bf16_t* __restrict__ og, PG8_LAS float* tab, int vcu, int G) {
    const int tid = opaque_tid();
    for (int i = tid; i < NH * TABN; i += 512) { const int hh_ = i / TABN, t = i % TABN; tab[i] = relb[hh_ * N_REL + (t < 256 ? t : 256)] * LOG2E; }
    __syncthreads();
    const int lane = tid & 63, wave = __builtin_amdgcn_readfirstlane(tid >> 6), l31 = lane & 31, hh = lane >> 5;
    const int pi = (l31 & 19) | ((l31 & 4) << 1) | ((l31 & 8) >> 1);
    for (int gw = vcu * 8 + wave; gw < BATCH * NH * 32; gw += G * 8) {
      const int bh = gw >> 5, b = bh >> 3, h = bh & 7;
      const PG8_LAS float* tabh = tab + h * TABN;
      const float c0l = tabh[256];
#pragma unroll 1
      for (int it = 0; it < 2; ++it) {
        const int n = it == 0 ? (gw & 31) : 63 - (gw & 31);
        const size_t tok0 = (size_t)b * SEQ + (size_t)n * CHUNK;
        const bf16_t* zq = z + tok0 * ZP + oq + h * HD;
        bf16x8 qf[2][4];
#pragma unroll
        for (int qt = 0; qt < 2; ++qt)
#pragma unroll
            for (int s = 0; s < 4; ++s) qf[qt][s] = *(const bf16x8*)(zq + (size_t)(qt * 32 + l31) * ZP + 16 * s + 8 * hh);
        f32x16 o[2][2];
#pragma unroll
        for (int dt = 0; dt < 2; ++dt)
#pragma unroll
            for (int qt = 0; qt < 2; ++qt)
#pragma unroll
                for (int r = 0; r < 16; ++r) o[dt][qt][r] = 0.f;
        float m_run[2] = {-1e30f, -1e30f}, l_run[2] = {0.f, 0.f};
        const int kc0 = n >= LEFT ? n - LEFT : 0;
#pragma unroll 1
        for (int kc = kc0; kc <= n; ++kc) {
            const int w = kc - n + LEFT;
            const size_t key0 = (size_t)b * SEQ + (size_t)kc * CHUNK;
            const bf16_t* zk = z + key0 * ZP + ok + h * HD;
            bf16x8 kf[2][4];
#pragma unroll
            for (int kt = 0; kt < 2; ++kt)
#pragma unroll
                for (int s = 0; s < 4; ++s) kf[kt][s] = *(const bf16x8*)(zk + (size_t)(kt * 32 + pi) * ZP + 16 * s + 8 * hh);
            u32x4 pw[2][2][2];
#pragma unroll
            for (int qt = 0; qt < 2; ++qt) {
                f32x16 sa[2];
#pragma unroll
                for (int kt = 0; kt < 2; ++kt) { f32x16 a;
#pragma unroll
                    for (int r = 0; r < 16; ++r) a[r] = 0.f;
#pragma unroll
                    for (int s = 0; s < 4; ++s) a = __builtin_amdgcn_mfma_f32_32x32x16_bf16(kf[kt][s], qf[qt][s], a, 0, 0, 0);
                    sa[kt] = a; }
                if (w <= 5) {
#pragma unroll
                    for (int kt = 0; kt < 2; ++kt)
#pragma unroll
                        for (int r = 0; r < 16; ++r) sa[kt][r] = sa[kt][r] * C1 + c0l;
                } else {
#pragma unroll
                    for (int kt = 0; kt < 2; ++kt) { const int base = qt * 32 + l31 + 128 - (w - LEFT) * CHUNK - kt * 32 - 8 * hh;
#pragma unroll
                        for (int r = 0; r < 16; ++r) sa[kt][r] = sa[kt][r] * C1 + tabh[base - (16 * (r >> 3) + (r & 7))]; }
                }
                float cm = fmaxf(sa[0][0], sa[1][0]);
#pragma unroll
                for (int r = 1; r < 16; ++r) cm = fmaxf(cm, fmaxf(sa[0][r], sa[1][r]));
                cm = fmaxf(cm, __shfl_xor(cm, 32));
                const float mn = fmaxf(m_run[qt], cm);
                const float alpha = __builtin_amdgcn_exp2f(m_run[qt] - mn);
                m_run[qt] = mn;
                float ps = 0.f;
#pragma unroll
                for (int kt = 0; kt < 2; ++kt) {
#pragma unroll
                    for (int r = 0; r < 16; ++r) { const float p = __builtin_amdgcn_exp2f(sa[kt][r] - mn); sa[kt][r] = p; ps += p; }
#pragma unroll
                    for (int s2 = 0; s2 < 2; ++s2) { u32x4 t4; t4.x = cvtpk_s(sa[kt][8 * s2 + 0], sa[kt][8 * s2 + 1]); t4.y = cvtpk_s(sa[kt][8 * s2 + 2], sa[kt][8 * s2 + 3]);
                        t4.z = cvtpk_s(sa[kt][8 * s2 + 4], sa[kt][8 * s2 + 5]); t4.w = cvtpk_s(sa[kt][8 * s2 + 6], sa[kt][8 * s2 + 7]); pw[qt][kt][s2] = t4; }
                }
                l_run[qt] = l_run[qt] * alpha + ps;
#pragma unroll
                for (int dt = 0; dt < 2; ++dt)
#pragma unroll
                    for (int r = 0; r < 16; ++r) o[dt][qt][r] *= alpha;
            }
            const bf16_t* vp = vt + (size_t)(h * HD + l31) * M + key0 + 8 * hh;
#pragma unroll
            for (int kt = 0; kt < 2; ++kt)
#pragma unroll
                for (int s2 = 0; s2 < 2; ++s2) {
                    bf16x8 vf[2];
#pragma unroll
                    for (int dt = 0; dt < 2; ++dt) vf[dt] = *(const bf16x8*)(vp + (size_t)(dt * 32) * M + kt * 32 + 16 * s2);
#pragma unroll
                    for (int qt = 0; qt < 2; ++qt) {
                        const bf16x8 pb = __builtin_bit_cast(bf16x8, pw[qt][kt][s2]);
#pragma unroll
                        for (int dt = 0; dt < 2; ++dt) o[dt][qt] = __builtin_amdgcn_mfma_f32_32x32x16_bf16(vf[dt], pb, o[dt][qt], 0, 0, 0);
                    }
                }
        }
#pragma unroll
        for (int qt = 0; qt < 2; ++qt) {
            const float lt = l_run[qt] + __shfl_xor(l_run[qt], 32);
            const float inv = 1.0f / lt;
            const size_t tok = tok0 + qt * 32 + l31;
            const bf16_t* gp = z + tok * ZP + oag + h * HD + 4 * hh;
            bf16_t* op = og + tok * DA + h * HD + 4 * hh;
#pragma unroll
            for (int dt = 0; dt < 2; ++dt)
#pragma unroll
                for (int g4 = 0; g4 < 4; ++g4) {
                    const uint2 gg = *(const uint2*)(gp + dt * 32 + 8 * g4);
                    const float v0 = o[dt][qt][4 * g4 + 0] * inv * siluf_(bflo(gg.x)), v1 = o[dt][qt][4 * g4 + 1] * inv * siluf_(bfhi(gg.x));
                    const float v2 = o[dt][qt][4 * g4 + 2] * inv * siluf_(bflo(gg.y)), v3 = o[dt][qt][4 * g4 + 3] * inv * siluf_(bfhi(gg.y));
                    uint2 ov; ov.x = cvtpk_s(v0, v1); ov.y = cvtpk_s(v2, v3);
                    *(uint2*)(op + dt * 32 + 8 * g4) = ov;
                }
        }
      }
    }
}

__device__ __forceinline__ void p_ln(float* __restrict__ out, const float* __restrict__ g, const float* __restrict__ bta) {
  const int tid_ = opaque_tid();
  for (int row = blockIdx.x * 8 + (tid_ >> 6); row < M; row += gridDim.x * 8) {
    const int lane = tid_ & 63;
    f32x4* p = (f32x4*)(out + (size_t)row * DM) + lane;
    f32x4 v[4]; float s = 0.f;
#pragma unroll
    for (int j = 0; j < 4; ++j) { v[j] = p[64 * j]; s += (v[j].x + v[j].y) + (v[j].z + v[j].w); }
#pragma unroll
    for (int o = 1; o < 64; o <<= 1) s += __shfl_xor(s, o);
    const float mean = s * (1.0f / DM); float s2 = 0.f;
#pragma unroll
    for (int j = 0; j < 4; ++j) { v[j] = v[j] - mean; s2 += (v[j].x * v[j].x + v[j].y * v[j].y) + (v[j].z * v[j].z + v[j].w * v[j].w); }
#pragma unroll
    for (int o = 1; o < 64; o <<= 1) s2 += __shfl_xor(s2, o);
    const float rstd = 1.0f / sqrtf(s2 * (1.0f / DM) + LN_EPS);
#pragma unroll
    for (int j = 0; j < 4; ++j) { const f32x4 gg = ((const f32x4*)g)[lane + 64 * j], bb = ((const f32x4*)bta)[lane + 64 * j]; p[64 * j] = v[j] * rstd * gg + bb; }
  }
}

constexpr int LDS_BYTES = 147456;
struct Params { const float* in[14]; float* out; unsigned char* ws; };
__global__ void __launch_bounds__(512, 2) fwd_megakernel(Params p) {
    cg::grid_group grid = cg::this_grid();
    extern __shared__ __attribute__((aligned(16))) unsigned char lds[];
    PG8_LAS unsigned char* ldsp = (PG8_LAS unsigned char*)lds;
    const float* x = p.in[0]; const float* w_in = p.in[1]; const float* b_in = p.in[2];
    const float* conv_w = p.in[3]; const float* conv_b = p.in[4]; const float* cln_g = p.in[5]; const float* cln_b = p.in[6];
    const float* w_co = p.in[7]; const float* relb = p.in[8]; const float* w_ao = p.in[9];
    const float* w_o = p.in[10]; const float* b_o = p.in[11]; const float* oln_g = p.in[12]; const float* oln_b = p.in[13];
    unsigned char* ws = p.ws; float* out = p.out;
    bf16_t* Win_t = (bf16_t*)(ws + WS_WIN); bf16_t* Wc_t = (bf16_t*)(ws + WS_WC); bf16_t* Wa_t = (bf16_t*)(ws + WS_WA); bf16_t* Wo_t = (bf16_t*)(ws + WS_WO);
    bf16_t* xb = (bf16_t*)(ws + WS_XB); bf16_t* hb = (bf16_t*)(ws + WS_H); bf16_t* z = (bf16_t*)(ws + WS_Z); bf16_t* uc = (bf16_t*)(ws + WS_UC); bf16_t* og = (bf16_t*)(ws + WS_OG);
    const int G = (int)gridDim.x, bid = (int)blockIdx.x;
    const int vcu = (G % 8 == 0) ? (bid % 8) * (G / 8) + bid / 8 : bid;
    p_cvt(x, xb, (size_t)M * DM / 8);
    p_transpose(w_in, Win_t, DM, DIN); p_transpose(w_co, Wc_t, DC, DM); p_transpose(w_ao, Wa_t, DA, DM); p_transpose(w_o, Wo_t, DM, DM);
    grid.sync();
    { pg8::Gemm g{xb, Win_t, M, DIN, DM}; pg8::StaticOrder S; S.init(M, DIN, G, bid);
      pg8::EpiBf16<0> E{z, DIN, b_in, 0, 0, 1.f};
      pg8::gemm_phase<pg8::EpiBf16<0>, pg8::StaticOrder, PG8_ALIGN, PG8_SP2>(ldsp, g, S, E); }
    bf16_t* vt = (bf16_t*)out;
    { pg8::Gemm g{Win_t + (size_t)O_V * DM, xb, DA, M, DM}; pg8::StaticOrder S; S.init(DA, M, G, bid);
      pg8::EpiVT E{vt, M, b_in + O_V};
      pg8::gemm_phase<pg8::EpiVT, pg8::StaticOrder, PG8_ALIGN, PG8_SP2>(ldsp, g, S, E); }
    grid.sync();
    p_conv(z, conv_w, conv_b, cln_g, cln_b, uc, (float (*)[CT])lds);
    __syncthreads();
    p_attn<DIN>(z, O_Q, O_K, O_AG, vt, relb, og, (PG8_LAS float*)ldsp, vcu, G);
    grid.sync();
    { pg8::Gemm g{uc, Wc_t, M, DM, DC}; pg8::StaticOrder S; S.init(M, DM, G, bid);
      pg8::EpiGate1 E{out, z, O_GC};
      pg8::gemm_phase<pg8::EpiGate1, pg8::StaticOrder, PG8_ALIGN, PG8_SP2>(ldsp, g, S, E); }
    { pg8::Gemm g{og, Wa_t, M, DM, DA}; pg8::StaticOrder S; S.init(M, DM, G, bid);
      pg8::EpiGate2 E{out, z, O_GA, hb};
      pg8::gemm_phase<pg8::EpiGate2, pg8::StaticOrder, PG8_ALIGN, PG8_SP2>(ldsp, g, S, E); }
    grid.sync();
    { pg8::Gemm g{hb, Wo_t, M, DM, DM}; pg8::StaticOrder S; S.init(M, DM, G, bid);
      pg8::EpiRes E{out, x, b_o};
      pg8::gemm_phase<pg8::EpiRes, pg8::StaticOrder, PG8_ALIGN, PG8_SP2>(ldsp, g, S, E); }
    grid.sync();
    p_ln(out, oln_g, oln_b);
}

extern "C" void kernel_launch(void* const* d_in, const int* in_sizes, int n_in, void* d_out, int out_size, void* d_ws, size_t ws_size, hipStream_t stream) {
    if (n_in != 14 || in_sizes[0] != M * DM || out_size != M * DM || ws_size < WS_END) { fprintf(stderr, "kernel_launch: unexpected shapes / workspace (n_in %d, ws %zu)\n", n_in, ws_size); return; }
    static int grid_blocks = 0;
    if (!grid_blocks) {
        int dev = 0, cus = 0, per_cu = 0;
        (void)hipGetDevice(&dev);
        (void)hipDeviceGetAttribute(&cus, hipDeviceAttributeMultiprocessorCount, dev);
        if (hipFuncSetAttribute((const void*)fwd_megakernel, hipFuncAttributeMaxDynamicSharedMemorySize, LDS_BYTES) != hipSuccess) fprintf(stderr, "kernel_launch: hipFuncSetAttribute failed\n");
        (void)hipOccupancyMaxActiveBlocksPerMultiprocessor(&per_cu, fwd_megakernel, 512, LDS_BYTES);
        if (per_cu < 1) { fprintf(stderr, "kernel_launch: occupancy query returned %d\n", per_cu); }
        grid_blocks = cus;
    }
    Params p{};
    for (int i = 0; i < 14; ++i) p.in[i] = (const float*)d_in[i];
    p.out = (float*)d_out; p.ws = (unsigned char*)d_ws;
    void* args[] = {&p};
    hipError_t e = hipLaunchCooperativeKernel((void*)fwd_megakernel, dim3(grid_blocks), dim3(512), args, LDS_BYTES, stream);
    if (e != hipSuccess) fprintf(stderr, "cooperative launch failed: %s (grid %d)\n", hipGetErrorString(e), grid_blocks);
}
```

```cpp
#include <hip/hip_runtime.h>
#include <hip/hip_cooperative_groups.h>
namespace cg = cooperative_groups;
#include <cstdio>
#include <cstdint>

typedef unsigned short bf16_t;
typedef short bf16x8 __attribute__((ext_vector_type(8)));
typedef float f32x4 __attribute__((ext_vector_type(4)));
typedef unsigned u32x4 __attribute__((ext_vector_type(4)));

constexpr int BATCH = 8, SEQ = 4096, DM = 1024, M = BATCH * SEQ;
constexpr int DC = 512, DA = 512, NH = 8, HD = 64, CW = 31, DIN = 5632, CHUNK = 64, NCH = SEQ / CHUNK, LEFT = 8;
constexpr int MAX_REL = 128, N_REL = 257;
constexpr int O_CVAL = 0, O_CGLU = 512, O_CGATE = 1024, O_Q = 1536, O_K = 2048, O_V = 2560, O_AG = 3072, O_GC = 3584, O_GA = 4608;
__host__ __device__ __forceinline__ int src_col(int d) { if (d < 1024) { const int t = d >> 8, j = d & 255; return j < 128 ? 128 * t + j : 512 + 128 * t + (j - 128); } return d < 2560 ? d : (d < 5120 ? d + 512 : d - 2560); }
constexpr int ZP = 4096, Z_CGATE = 0, Z_Q = 512, Z_K = 1024, Z_AG = 1536, Z_GC = 2048, Z_GA = 3072, N1 = 5120;
constexpr float LN_EPS = 1e-5f;
constexpr float ALPHA = 1.189207115002721f;

constexpr size_t MiB = 1u << 20;
constexpr size_t WS_WIN = 2 * MiB, WS_WC = 14 * MiB, WS_WA = 15 * MiB, WS_WO = 16 * MiB;
constexpr size_t WS_XB = 32 * MiB;
constexpr size_t WS_H = 32 * MiB;
constexpr size_t WS_Z = 96 * MiB;
constexpr size_t WS_U = 352 * MiB;
constexpr size_t WS_VT = 384 * MiB;
constexpr size_t WS_UC = 416 * MiB;
constexpr size_t WS_OG = 448 * MiB;
constexpr size_t WS_END = 480 * MiB;

__device__ __forceinline__ unsigned f2bf(float f) { unsigned u = __builtin_bit_cast(unsigned, f); return (u + 0x7fffu + ((u >> 16) & 1u)) >> 16; }
__device__ __forceinline__ unsigned pk2(float lo, float hi) { return f2bf(lo) | (f2bf(hi) << 16); }
__device__ __forceinline__ float bf2f(bf16_t b) { return __uint_as_float(((unsigned)b) << 16); }
__device__ __forceinline__ float bflo(unsigned w) { return __uint_as_float(w << 16); }
__device__ __forceinline__ float bfhi(unsigned w) { return __uint_as_float(w & 0xffff0000u); }
__device__ __forceinline__ float sigmoidf_(float x) { return 1.0f / (1.0f + __expf(-x)); }
__device__ __forceinline__ float siluf_(float x) { return x / (1.0f + __expf(-x)); }

__device__ __forceinline__ int opaque_tid() { int t = (int)threadIdx.x; asm volatile("" : "+v"(t)); return t; }
__device__ __forceinline__ void p_cvt(const float* __restrict__ x, bf16_t* __restrict__ xb, size_t n8) {
    for (size_t i = (size_t)blockIdx.x * blockDim.x + opaque_tid(); i < n8; i += (size_t)gridDim.x * blockDim.x) {
        const f32x4 a = ((const f32x4*)x)[2 * i], b = ((const f32x4*)x)[2 * i + 1];
        u32x4 o; o.x = pk2(a.x, a.y); o.y = pk2(a.z, a.w); o.z = pk2(b.x, b.y); o.w = pk2(b.z, b.w);
        ((u32x4*)xb)[i] = o;
    }
}
#define LAS3 __attribute__((address_space(3)))
__device__ __forceinline__ void transpose_item(const float* __restrict__ W, int K, int N, bf16_t* __restrict__ WT, int k0, int n0src, int n0dst, LAS3 float* scr, int lane) {
#pragma unroll 8
    for (int i = 0; i < 32; ++i) { const int kk = 2 * i + (lane >> 5); scr[kk * 33 + (lane & 31)] = W[(size_t)(k0 + kk) * N + n0src + (lane & 31)]; }
    asm volatile("s_waitcnt lgkmcnt(0)" ::: "memory");
    const int c = lane & 7;
#pragma unroll
    for (int j = 0; j < 4; ++j) { const int n = (lane >> 3) + 8 * j; const LAS3 float* s = scr + (8 * c) * 33 + n;
        u32x4 o; o.x = pk2(s[0 * 33], s[1 * 33]); o.y = pk2(s[2 * 33], s[3 * 33]); o.z = pk2(s[4 * 33], s[5 * 33]); o.w = pk2(s[6 * 33], s[7 * 33]);
        *(u32x4*)(WT + (size_t)(n0dst + n) * K + k0 + 8 * c) = o; }
    asm volatile("s_waitcnt lgkmcnt(0)" ::: "memory");
}
__device__ __forceinline__ void p_weights(const float* w_in, const float* w_co, const float* w_ao, const float* w_o, bf16_t* Win_t, bf16_t* Wc_t, bf16_t* Wa_t, bf16_t* Wo_t, LAS3 unsigned char* lds, int gw, int NGW) {
    const int tid = opaque_tid(), lane = tid & 63, wave = __builtin_amdgcn_readfirstlane(tid >> 6);
    LAS3 float* scr = (LAS3 float*)(lds + wave * 16384);
    constexpr int I_IN = (DM / 64) * (DIN / 32), I_C = (DC / 64) * (DM / 32), I_O = (DM / 64) * (DM / 32), NITEMS = I_IN + 2 * I_C + I_O;
    for (int it = gw; it < NITEMS; it += NGW) {
        int r = it;
        if (r < I_IN) { const int nb = r % (DIN / 32), kb = r / (DIN / 32); transpose_item(w_in, DM, DIN, Win_t, 64 * kb, src_col(32 * nb), 32 * nb, scr, lane); continue; } r -= I_IN;
        if (r < I_C) { const int nb = r % (DM / 32), kb = r / (DM / 32); transpose_item(w_co, DC, DM, Wc_t, 64 * kb, 32 * nb, 32 * nb, scr, lane); continue; } r -= I_C;
        if (r < I_C) { const int nb = r % (DM / 32), kb = r / (DM / 32); transpose_item(w_ao, DA, DM, Wa_t, 64 * kb, 32 * nb, 32 * nb, scr, lane); continue; } r -= I_C;
        { const int nb = r % (DM / 32), kb = r / (DM / 32); transpose_item(w_o, DM, DM, Wo_t, 64 * kb, 32 * nb, 32 * nb, scr, lane); }
    }
}

namespace pg8 {
#define PG8_LAS __attribute__((address_space(3)))
typedef unsigned short bf16_t;
typedef short bf16x8 __attribute__((ext_vector_type(8)));
typedef float f32x4 __attribute__((ext_vector_type(4)));
typedef unsigned u32x4 __attribute__((ext_vector_type(4)));
constexpr int BM = 256, BK = 64, HALF = 128, HTB = HALF * BK * 2  , STAGE_BYTES = 8 * HTB, NXCD = 8, WGM = 8;

__host__ __device__ __forceinline__ int lds_byte(int r, int c) { const int st = (r >> 4) * 2 + (c >> 5), rr = r & 15, cc = c & 31, ob = rr * 64 + cc * 2; return st * 1024 + (ob ^ (((ob >> 9) & 1) << 5)); }
__host__ __device__ __forceinline__ void stage_rc(int b, int& R, int& C) { const int st = b / 1024, sb = b % 1024, swz = sb ^ (((sb >> 9) & 1) << 5); R = (st >> 1) * 16 + swz / 64; C = (st & 1) * 32 + (swz % 64) / 2; }
__host__ __device__ __forceinline__ int perm32(int rho) { const int n = rho >> 4, i = rho & 15; return 8 * (i >> 2) + 4 * n + (i & 3); }

struct Unit { int pm, pn; };
struct Gemm { const bf16_t* A; const bf16_t* Bt; int M, N, K; };

struct StaticOrder {
    int nM, nN, nwg, G, c;
    __host__ __device__ void init(int M, int N, int G_, int c_) { nM = M / BM; nN = N / BM; nwg = nM * nN; G = G_; c = c_; }
    __host__ __device__ bool next(int i, Unit& u) const {
        const long L = (long)i * G + c; if (L >= nwg) return false;
        int wgid = (int)L; { const int q = nwg / NXCD, r = nwg % NXCD, xcd = wgid % NXCD, off = wgid / NXCD; wgid = (xcd < r ? xcd * (q + 1) : r * (q + 1) + (xcd - r) * q) + off; }
        const int nig = WGM * nN, gid = wgid / nig, fm = gid * WGM, gsz = (nM - fm) < WGM ? (nM - fm) : WGM;
        u.pm = fm + ((wgid % nig) % gsz); u.pn = (wgid % nig) / gsz; return true;
    }
    __device__ __forceinline__ void a_ready(const Unit&) const {}
    __device__ __forceinline__ void done(const Unit&) const {}
};

__device__ __forceinline__ unsigned cvt_pk_bf16(float lo, float hi) { unsigned r; asm volatile("v_cvt_pk_bf16_f32 %0, %1, %2" : "=v"(r) : "v"(lo), "v"(hi)); return r; }
typedef float f32x2 __attribute__((ext_vector_type(2)));
__device__ __forceinline__ f32x2 gelu_pk(f32x2 v) {
    const f32x2 av = __builtin_elementwise_abs(v), d = av * 0.2316418882f + 1.0f;
    f32x2 t; t.x = __builtin_amdgcn_rcpf(d.x); t.y = __builtin_amdgcn_rcpf(d.y);
    f32x2 q = t * 0.5307027145f + (-0.7265760135f); q = q * t + 0.7107068705f; q = q * t + (-0.142248368f); q = q * t + 0.127414796f; q = q * t;
    const f32x2 s = (v * v) * (-0.72134752044f);
    f32x2 e; e.x = __builtin_amdgcn_exp2f(s.x); e.y = __builtin_amdgcn_exp2f(s.y);
    const f32x2 m = v * (q * e), r = v - m;
    f32x2 o; o.x = v.x < 0.f ? m.x : r.x; o.y = v.y < 0.f ? m.y : r.y; return o;
}

template <int ACT  > struct EpiBf16 {
    static constexpr bool PERM = true, AFTER_DRAIN = false; static_assert(ACT == 0 || ACT == 1, "EpiBf16: ACT is 0 (none) or 1 (gelu_pk)");
    bf16_t* O; int ldc; const float* bias; int split_cols; size_t split_stride; float scale0;
    __device__ __forceinline__ void operator()(const f32x4 (&acc)[2][2][4][2], const Unit& u, int wr, int wc, int fr, int fq) const {
        const int row0 = u.pm * BM + wr * 64 + fr; int colt = u.pn * BM; bf16_t* base = O;
        float sc = 1.f; if (split_cols) { const int t = colt / split_cols; base += (size_t)t * split_stride; colt -= t * split_cols; if (t == 0) sc = scale0; }
        const int col0 = colt + wc * 32 + 8 * fq, bcol0 = u.pn * BM + wc * 32 + 8 * fq;
        f32x4 bv[2][2];
#pragma unroll
        for (int bj = 0; bj < 2; ++bj)
#pragma unroll
            for (int n = 0; n < 2; ++n) bv[bj][n] = bias ? *(const f32x4*)(bias + bcol0 + bj * HALF + 4 * n) : (f32x4){0.f, 0.f, 0.f, 0.f};
#pragma unroll
        for (int ai = 0; ai < 2; ++ai)
#pragma unroll
            for (int m = 0; m < 4; ++m) { bf16_t* rowp = base + (size_t)(row0 + ai * HALF + m * 16) * ldc + col0;
#pragma unroll
                for (int bj = 0; bj < 2; ++bj) { f32x4 v0 = acc[ai][bj][m][0] + bv[bj][0], v1 = acc[ai][bj][m][1] + bv[bj][1];
                    if (ACT == 1) { f32x2 a = gelu_pk((f32x2){v0[0], v0[1]}), b = gelu_pk((f32x2){v0[2], v0[3]}), c = gelu_pk((f32x2){v1[0], v1[1]}), d = gelu_pk((f32x2){v1[2], v1[3]});
                        v0 = (f32x4){a.x, a.y, b.x, b.y}; v1 = (f32x4){c.x, c.y, d.x, d.y}; }
                    v0 = v0 * sc; v1 = v1 * sc; u32x4 w; w.x = cvt_pk_bf16(v0[0], v0[1]); w.y = cvt_pk_bf16(v0[2], v0[3]); w.z = cvt_pk_bf16(v1[0], v1[1]); w.w = cvt_pk_bf16(v1[2], v1[3]);
                    *(u32x4*)(rowp + bj * HALF) = w; } }
    }
};

struct PanelStats {
    unsigned* xbuf;
    unsigned* cnt;
    unsigned* tmo;
    int ntn; float eps;
    unsigned code;
    __device__ __forceinline__ bool run(const f32x4 (&v)[2][2][4][2], const Unit& u, int wr, int wc, int fr, int fq, PG8_LAS unsigned char* lds, int wid, int lane) const {
        typedef float f32x2v __attribute__((ext_vector_type(2)));
        PG8_LAS f32x2v* P = (PG8_LAS f32x2v*)lds;
        PG8_LAS f32x2v* S = (PG8_LAS f32x2v*)(lds + 8192);
        PG8_LAS unsigned* flag = (PG8_LAS unsigned*)(lds + 8192 + 2048);
#pragma unroll
        for (int ai = 0; ai < 2; ++ai)
#pragma unroll
            for (int m = 0; m < 4; ++m) {
                float s = 0.f;
#pragma unroll
                for (int bj = 0; bj < 2; ++bj)
#pragma unroll
                    for (int n = 0; n < 2; ++n) { const f32x4 x = v[ai][bj][m][n]; s += (x[0] + x[1]) + (x[2] + x[3]); }
                s += __shfl_xor(s, 16); s += __shfl_xor(s, 32);
                const float mw = s * (1.0f / 64.0f); float q = 0.f;
#pragma unroll
                for (int bj = 0; bj < 2; ++bj)
#pragma unroll
                    for (int n = 0; n < 2; ++n) { const f32x4 d = v[ai][bj][m][n] - mw; q += (d[0] * d[0] + d[1] * d[1]) + (d[2] * d[2] + d[3] * d[3]); }
                q += __shfl_xor(q, 16); q += __shfl_xor(q, 32);
                if (fq == 0) P[(ai * HALF + wr * 64 + m * 16 + fr) * 4 + wc] = (f32x2v){mw, q};
            }
        asm volatile("s_waitcnt lgkmcnt(0)" ::: "memory"); __builtin_amdgcn_s_barrier(); asm volatile("" ::: "memory");
#if defined(BROKEN_EXCHANGE_NO_WAIT)
#warning BROKEN CONTROL BUILD: the row-statistics exchange does not wait; results are wrong by design
        if (blockIdx.x >= 64) { const long long t0_ = clock64(); while (clock64() - t0_ < 60000) __builtin_amdgcn_s_sleep(8); }
#endif
        const int row = wid * 32 + (lane & 31);
        if (lane < 32) {
            const f32x2v a = P[row * 4 + 0], b = P[row * 4 + 1], c = P[row * 4 + 2], d = P[row * 4 + 3];
            const float mt = (a.x + b.x + c.x + d.x) * 0.25f;
            const float da = a.x - mt, db = b.x - mt, dc = c.x - mt, dd = d.x - mt;
            const float m2 = (a.y + b.y) + (c.y + d.y) + 64.0f * ((da * da + db * db) + (dc * dc + dd * dd));
            unsigned long long* slot = (unsigned long long*)xbuf + ((size_t)(u.pm * BM + row) * 4 + u.pn);
            __hip_atomic_store(slot, ((unsigned long long)__float_as_uint(m2) << 32) | __float_as_uint(mt), __ATOMIC_RELAXED, __HIP_MEMORY_SCOPE_AGENT);
        }
        asm volatile("s_waitcnt vmcnt(0)" ::: "memory");
        if (lane == 0) __hip_atomic_fetch_add(cnt + 64 * u.pm, 1u, __ATOMIC_RELAXED, __HIP_MEMORY_SCOPE_AGENT);
        if (wid == 0) {
            bool dead = false; const unsigned long long t0 = __builtin_amdgcn_s_memrealtime(); const unsigned want = 8u * (unsigned)ntn;
            for (;;) {
#if defined(BROKEN_EXCHANGE_NO_WAIT)
                break;
#endif
                if ((unsigned)__builtin_amdgcn_readfirstlane(__hip_atomic_load(cnt + 64 * u.pm, __ATOMIC_RELAXED, __HIP_MEMORY_SCOPE_AGENT)) >= want) break;
                if (__builtin_amdgcn_s_memrealtime() - t0 > 2000000ull) {
                    if (lane == 0) { unsigned expect = 0u; __hip_atomic_compare_exchange_strong(tmo + 1, &expect, code | (unsigned)(u.pm & 0xff), __ATOMIC_RELAXED, __ATOMIC_RELAXED, __HIP_MEMORY_SCOPE_AGENT);
                                     __hip_atomic_store(tmo, 1u, __ATOMIC_RELAXED, __HIP_MEMORY_SCOPE_AGENT); }
                    dead = true; break; }
                __builtin_amdgcn_s_sleep(2);
            }
            __builtin_amdgcn_fence(__ATOMIC_ACQUIRE, "agent");
            if (lane == 0) flag[0] = dead ? 1u : 0u;
        }
        asm volatile("s_waitcnt vmcnt(0) lgkmcnt(0)" ::: "memory"); __builtin_amdgcn_s_barrier(); asm volatile("" ::: "memory");
        const bool bad = flag[0] != 0u;
        if (lane < 32) {
            const unsigned long long* slot = (const unsigned long long*)xbuf + (size_t)(u.pm * BM + row) * 4; float mt[4], m2[4]; float ms = 0.f;
#pragma unroll
            for (int t = 0; t < 4; ++t) { if (t < ntn) { const unsigned long long w = __hip_atomic_load(slot + t, __ATOMIC_RELAXED, __HIP_MEMORY_SCOPE_AGENT); mt[t] = __uint_as_float((unsigned)w); m2[t] = __uint_as_float((unsigned)(w >> 32)); } else { mt[t] = 0.f; m2[t] = 0.f; } ms += mt[t]; }
            const float mean = ms / (float)ntn; float q = 0.f;
#pragma unroll
            for (int t = 0; t < 4; ++t) if (t < ntn) { const float dm = mt[t] - mean; q += m2[t] + 256.0f * dm * dm; }
            S[row] = (f32x2v){mean, 1.0f / sqrtf(q / (256.0f * (float)ntn) + eps)};
        }
        asm volatile("s_waitcnt lgkmcnt(0)" ::: "memory"); __builtin_amdgcn_s_barrier(); asm volatile("" ::: "memory");
        return bad;
    }
};
struct EpiLnRes {
    static constexpr bool PERM = false, AFTER_DRAIN = true;
    const float* base; float* out; int ldc; const float* bias; PanelStats st; unsigned poison;
    __device__ __forceinline__ void fused(f32x4 (&acc)[2][2][4][2], const Unit& u, int wr, int wc, int fr, int fq, PG8_LAS unsigned char* lds, int wid, int lane) const {
        typedef float f32x2v __attribute__((ext_vector_type(2)));
        const PG8_LAS f32x2v* S = (const PG8_LAS f32x2v*)(lds + 8192);
        const int col0 = u.pn * BM + wc * 32 + 4 * fq;
#pragma unroll
        for (int bj = 0; bj < 2; ++bj)
#pragma unroll
            for (int n = 0; n < 2; ++n) { const f32x4 bv = bias ? *(const f32x4*)(bias + col0 + bj * HALF + n * 16) : (f32x4){0.f, 0.f, 0.f, 0.f};
#pragma unroll
                for (int ai = 0; ai < 2; ++ai)
#pragma unroll
                    for (int m = 0; m < 4; ++m) acc[ai][bj][m][n] += bv; }
        f32x4 pre[4][2][2];
#pragma unroll
        for (int m = 0; m < 4; ++m) { const size_t off = (size_t)(u.pm * BM + wr * 64 + m * 16 + fr) * ldc + col0;
#pragma unroll
            for (int bj = 0; bj < 2; ++bj)
#pragma unroll
                for (int n = 0; n < 2; ++n) pre[m][bj][n] = *(const f32x4*)(base + off + bj * HALF + n * 16); }
        const bool bad = st.run(acc, u, wr, wc, fr, fq, lds, wid, lane) || poison != 0u;
        const float qnan = __builtin_nanf("");
#pragma unroll
        for (int ai = 0; ai < 2; ++ai)
#pragma unroll
            for (int m = 0; m < 4; ++m) { const int r = ai * HALF + wr * 64 + m * 16 + fr; const f32x2v sr = S[r]; const size_t off = (size_t)(u.pm * BM + r) * ldc + col0;
#pragma unroll
                for (int bj = 0; bj < 2; ++bj)
#pragma unroll
                    for (int n = 0; n < 2; ++n) { const f32x4 bs = ai == 0 ? pre[m][bj][n] : *(const f32x4*)(base + off + bj * HALF + n * 16); f32x4 o = bs + (acc[ai][bj][m][n] - sr.x) * sr.y;
                        if (bad) o = (f32x4){qnan, qnan, qnan, qnan}; *(f32x4*)(out + off + bj * HALF + n * 16) = o; }
                if (m & 1) asm volatile("" ::: "memory"); }
    }
};
struct EpiLnResLn {
    static constexpr bool PERM = false, AFTER_DRAIN = true;
    const float* base; float* out; bf16_t* xn; int ldc; const float* bias; PanelStats st1, st2; unsigned poison;
    __device__ __forceinline__ void fused(f32x4 (&acc)[2][2][4][2], const Unit& u, int wr, int wc, int fr, int fq, PG8_LAS unsigned char* lds, int wid, int lane) const {
        typedef float f32x2v __attribute__((ext_vector_type(2))); typedef unsigned u32x2v __attribute__((ext_vector_type(2)));
        const PG8_LAS f32x2v* S = (const PG8_LAS f32x2v*)(lds + 8192);
        const int col0 = u.pn * BM + wc * 32 + 4 * fq;
#pragma unroll
        for (int bj = 0; bj < 2; ++bj)
#pragma unroll
            for (int n = 0; n < 2; ++n) { const f32x4 bv = bias ? *(const f32x4*)(bias + col0 + bj * HALF + n * 16) : (f32x4){0.f, 0.f, 0.f, 0.f};
#pragma unroll
                for (int ai = 0; ai < 2; ++ai)
#pragma unroll
                    for (int m = 0; m < 4; ++m) acc[ai][bj][m][n] += bv; }
        bool bad = st1.run(acc, u, wr, wc, fr, fq, lds, wid, lane) || poison != 0u;
        const float qnan = __builtin_nanf("");
#pragma unroll
        for (int ai = 0; ai < 2; ++ai)
#pragma unroll
            for (int m = 0; m < 4; ++m) { const int r = ai * HALF + wr * 64 + m * 16 + fr; const f32x2v sr = S[r]; const size_t off = (size_t)(u.pm * BM + r) * ldc + col0;
#pragma unroll
                for (int bj = 0; bj < 2; ++bj)
#pragma unroll
                    for (int n = 0; n < 2; ++n) { const f32x4 bs = *(const f32x4*)(base + off + bj * HALF + n * 16); acc[ai][bj][m][n] = bs + (acc[ai][bj][m][n] - sr.x) * sr.y; }
                asm volatile("" : "+v"(acc[ai][0][m][0]), "+v"(acc[ai][0][m][1]), "+v"(acc[ai][1][m][0]), "+v"(acc[ai][1][m][1]));
                if (m & 1) asm volatile("" ::: "memory"); }
        const bool bad1 = bad;
        bad = st2.run(acc, u, wr, wc, fr, fq, lds, wid, lane) || bad;
#pragma unroll
        for (int ai = 0; ai < 2; ++ai)
#pragma unroll
            for (int m = 0; m < 4; ++m) { const int r = ai * HALF + wr * 64 + m * 16 + fr; const f32x2v sr = S[r]; const size_t off = (size_t)(u.pm * BM + r) * ldc + col0;
#pragma unroll
                for (int bj = 0; bj < 2; ++bj)
#pragma unroll
                    for (int n = 0; n < 2; ++n) { const f32x4 x1 = acc[ai][bj][m][n]; *(f32x4*)(out + off + bj * HALF + n * 16) = bad1 ? (f32x4){qnan, qnan, qnan, qnan} : x1;
                        const f32x4 o = (x1 - sr.x) * sr.y; u32x2v w; w.x = cvt_pk_bf16(o[0], o[1]); w.y = cvt_pk_bf16(o[2], o[3]);
                        if (bad) { w.x = 0x7fc07fc0u; w.y = 0x7fc07fc0u; } *(u32x2v*)(xn + off + bj * HALF + n * 16) = w; }
                asm volatile("" ::: "memory"); }
    }
};

template <class Epi, class Sched, bool ALIGN_EPI = false, bool SP2 = false>
__device__ __forceinline__ void gemm_phase(PG8_LAS unsigned char* lds, const Gemm g, const Sched& S, const Epi& E) {
    const int tid = opaque_tid(), wid = __builtin_amdgcn_readfirstlane(tid >> 6), lane = tid & 63, wr = wid >> 2, wc = wid & 3, fr = lane & 15, fq = lane >> 4;
    const int K = g.K, nt = K / BK;
    unsigned voffA[2], voffB[2];
#pragma unroll
    for (int i = 0; i < 2; ++i) { int R, C; stage_rc(tid * 16 + i * 8192, R, C); const int Rb = Epi::PERM ? ((R & ~31) + perm32(R & 31)) : R;
        voffA[i] = (unsigned)(R * K + C) * 2u; voffB[i] = (unsigned)(Rb * K + C) * 2u; }
    const size_t kstep = (size_t)(BK * 2);
    const size_t hstep = (size_t)HALF * K * 2;
    const size_t tstep = 2 * hstep;
    const unsigned ldsw = (unsigned)wid * 1024u;
    const int aoff = lds_byte(wr * 64 + fr, fq * 8), boff = lds_byte(wc * 32 + fr, fq * 8);
#define PG8_SA(b, h) (((b) * 2 + (h)) * HTB)
#define PG8_SB(b, h) ((4 + (b) * 2 + (h)) * HTB)
#define PG8_STAGE(bufoff, gbase, voff) do { _Pragma("unroll") for (int _i = 0; _i < 2; ++_i) \
        __builtin_amdgcn_global_load_lds((const unsigned*)((const char*)(gbase) + (voff)[_i]), (PG8_LAS unsigned*)(lds + (bufoff) + ldsw + _i * 8192), 16, 0, 0); } while (0)
#define PG8_LDA(dst, b, h) do { _Pragma("unroll") for (int m = 0; m < 4; ++m) _Pragma("unroll") for (int k = 0; k < 2; ++k) dst[m][k] = *(const PG8_LAS bf16x8*)(lds + PG8_SA(b, h) + aoff + m * 2048 + k * 1024); } while (0)
#define PG8_LDB(dst, b, h) do { _Pragma("unroll") for (int n = 0; n < 2; ++n) _Pragma("unroll") for (int k = 0; k < 2; ++k) dst[n][k] = *(const PG8_LAS bf16x8*)(lds + PG8_SB(b, h) + boff + n * 2048 + k * 1024); } while (0)
#define PG8_MMA(ai, bj, At, Bt) do { __builtin_amdgcn_s_setprio(1); _Pragma("unroll") for (int m = 0; m < 4; ++m) _Pragma("unroll") for (int n = 0; n < 2; ++n) _Pragma("unroll") for (int k = 0; k < 2; ++k) \
        acc[ai][bj][m][n] = __builtin_amdgcn_mfma_f32_16x16x32_bf16(Bt[n][k], At[m][k], acc[ai][bj][m][n], 0, 0, 0); __builtin_amdgcn_s_setprio(0); } while (0)
#define PG8_WAIT_V(n) asm volatile("s_waitcnt vmcnt(" #n ")" ::: "memory")
#define PG8_WAIT_L(n) asm volatile("s_waitcnt lgkmcnt(" #n ")" ::: "memory")
#define PG8_BAR __builtin_amdgcn_s_barrier()
#define PG8_SCHED __builtin_amdgcn_sched_barrier(0)
    Unit cur, nxt; int ui = 0;
    if (!S.next(0, cur)) return;
    f32x4 acc[2][2][4][2];
#pragma unroll
    for (int a = 0; a < 2; ++a)
#pragma unroll
        for (int b = 0; b < 2; ++b)
#pragma unroll
            for (int m = 0; m < 4; ++m)
#pragma unroll
                for (int n = 0; n < 2; ++n) acc[a][b][m][n] = (f32x4){0.f, 0.f, 0.f, 0.f};
    bf16x8 At[4][2], B0[2][2], B1[2][2];
    const char* cA = (const char*)g.A + (size_t)cur.pm * tstep; const char* cB = (const char*)g.Bt + (size_t)cur.pn * tstep;
    S.a_ready(cur);
    if constexpr (SP2) {
        PG8_STAGE(PG8_SB(0, 0), cB, voffB); PG8_STAGE(PG8_SB(0, 1), cB + hstep, voffB); PG8_STAGE(PG8_SA(0, 0), cA, voffA); PG8_STAGE(PG8_SA(0, 1), cA + hstep, voffA);
        if (wr == 1) PG8_BAR;
        PG8_WAIT_V(2); PG8_BAR;
        PG8_STAGE(PG8_SB(1, 0), cB + kstep, voffB); PG8_STAGE(PG8_SA(1, 0), cA + kstep, voffA); PG8_STAGE(PG8_SB(1, 1), cB + hstep + kstep, voffB);
        PG8_WAIT_V(6); PG8_BAR;
    } else {
        PG8_STAGE(PG8_SB(0, 0), cB, voffB); PG8_STAGE(PG8_SA(0, 0), cA, voffA); PG8_STAGE(PG8_SB(0, 1), cB + hstep, voffB); PG8_STAGE(PG8_SA(0, 1), cA + hstep, voffA);
        if (wr == 1) PG8_BAR;
        PG8_WAIT_V(4); PG8_BAR;
        PG8_STAGE(PG8_SB(1, 0), cB + kstep, voffB); PG8_STAGE(PG8_SA(1, 0), cA + kstep, voffA); PG8_STAGE(PG8_SB(1, 1), cB + hstep + kstep, voffB);
        PG8_WAIT_V(6); PG8_BAR;
    }
    for (;;) {
        const bool has_next = S.next(ui + 1, nxt);
        const char* nA = has_next ? (const char*)g.A + (size_t)nxt.pm * tstep : cA; const char* nB = has_next ? (const char*)g.Bt + (size_t)nxt.pn * tstep : cB;
        for (int t = 0; t < nt; t += 2) {
            const bool last = (t == nt - 2);
            const char* a1 = cA + (size_t)(t + 1) * kstep;
            const char* a2 = last ? nA : cA + (size_t)(t + 2) * kstep; const char* b2 = last ? nB : cB + (size_t)(t + 2) * kstep;
            const char* a3 = a2 + kstep; const char* b3 = b2 + kstep;
            if (last && has_next) S.a_ready(nxt);
            if constexpr (SP2) {
            PG8_LDB(B0, 0, 0); PG8_LDB(B1, 0, 1); PG8_SCHED; PG8_LDA(At, 0, 0); PG8_STAGE(PG8_SA(1, 1), a1 + hstep, voffA);
            PG8_WAIT_V(8); PG8_WAIT_L(0); PG8_BAR; PG8_MMA(0, 0, At, B0); PG8_MMA(0, 1, At, B1); PG8_BAR; PG8_SCHED;
            PG8_LDA(At, 0, 1); PG8_STAGE(PG8_SB(0, 0), b2, voffB); PG8_STAGE(PG8_SB(0, 1), b2 + hstep, voffB); PG8_STAGE(PG8_SA(0, 0), a2, voffA);
            PG8_WAIT_V(8); PG8_WAIT_L(0); PG8_BAR; PG8_MMA(1, 0, At, B0); PG8_MMA(1, 1, At, B1); PG8_BAR; PG8_SCHED;
            PG8_LDB(B0, 1, 0); PG8_LDB(B1, 1, 1); PG8_SCHED; PG8_LDA(At, 1, 0); PG8_STAGE(PG8_SA(0, 1), a2 + hstep, voffA);
            PG8_WAIT_V(8); PG8_WAIT_L(0); PG8_BAR; PG8_MMA(0, 0, At, B0); PG8_MMA(0, 1, At, B1); PG8_BAR; PG8_SCHED;
            PG8_LDA(At, 1, 1); PG8_STAGE(PG8_SB(1, 0), b3, voffB); PG8_STAGE(PG8_SB(1, 1), b3 + hstep, voffB); PG8_STAGE(PG8_SA(1, 0), a3, voffA);
            PG8_WAIT_V(8); PG8_WAIT_L(0); PG8_BAR; PG8_MMA(1, 0, At, B0); PG8_MMA(1, 1, At, B1); PG8_BAR; PG8_SCHED;
            } else {
            PG8_LDB(B0, 0, 0); PG8_SCHED; PG8_LDA(At, 0, 0); PG8_STAGE(PG8_SA(1, 1), a1 + hstep, voffA);
            PG8_WAIT_L(8); PG8_BAR; PG8_WAIT_L(0); PG8_MMA(0, 0, At, B0); PG8_BAR; PG8_SCHED;
            PG8_LDB(B1, 0, 1); PG8_STAGE(PG8_SB(0, 0), b2, voffB);
            PG8_BAR; PG8_WAIT_L(0); PG8_MMA(0, 1, At, B1); PG8_BAR;
            PG8_LDA(At, 0, 1); PG8_STAGE(PG8_SA(0, 0), a2, voffA);
            PG8_BAR; PG8_WAIT_L(0); PG8_MMA(1, 0, At, B0); PG8_BAR; PG8_SCHED;
            PG8_STAGE(PG8_SB(0, 1), b2 + hstep, voffB);
            PG8_WAIT_V(6); PG8_BAR; PG8_MMA(1, 1, At, B1); PG8_BAR;
            PG8_LDB(B0, 1, 0); PG8_SCHED; PG8_LDA(At, 1, 0); PG8_STAGE(PG8_SA(0, 1), a2 + hstep, voffA);
            PG8_WAIT_L(8); PG8_BAR; PG8_WAIT_L(0); PG8_MMA(0, 0, At, B0); PG8_BAR; PG8_SCHED;
            PG8_LDB(B1, 1, 1); PG8_STAGE(PG8_SB(1, 0), b3, voffB);
            PG8_BAR; PG8_WAIT_L(0); PG8_MMA(0, 1, At, B1); PG8_BAR;
            PG8_LDA(At, 1, 1); PG8_STAGE(PG8_SA(1, 0), a3, voffA);
            PG8_BAR; PG8_WAIT_L(0); PG8_MMA(1, 0, At, B0); PG8_BAR; PG8_SCHED;
            PG8_STAGE(PG8_SB(1, 1), b3 + hstep, voffB);
            PG8_WAIT_V(6); PG8_BAR; PG8_MMA(1, 1, At, B1); PG8_BAR;
            }
        }
        if constexpr (ALIGN_EPI) { if (wr == 0) PG8_BAR; }
        if constexpr (!Epi::AFTER_DRAIN) { E(acc, cur, wr, wc, fr, fq); S.done(cur); }
        if (!has_next) break;
#pragma unroll
        for (int a = 0; a < 2; ++a)
#pragma unroll
            for (int b = 0; b < 2; ++b)
#pragma unroll
                for (int m = 0; m < 4; ++m)
#pragma unroll
                    for (int n = 0; n < 2; ++n) acc[a][b][m][n] = (f32x4){0.f, 0.f, 0.f, 0.f};
        cur = nxt; cA = nA; cB = nB; ++ui;
        if constexpr (ALIGN_EPI) { if (wr == 1) PG8_BAR; }
    }
    PG8_WAIT_V(0);
    if constexpr (!ALIGN_EPI) { if (wr == 0) PG8_BAR; }
    PG8_BAR;
    if constexpr (Epi::AFTER_DRAIN) { E.fused(acc, cur, wr, wc, fr, fq, lds, wid, lane); S.done(cur); }
#undef PG8_SA
#undef PG8_SB
#undef PG8_STAGE
#undef PG8_LDA
#undef PG8_LDB
#undef PG8_MMA
#undef PG8_WAIT_V
#undef PG8_WAIT_L
#undef PG8_BAR
#undef PG8_SCHED
}
}

#ifndef PG8_SP2
#define PG8_SP2 true
#endif
#ifndef PG8_ALIGN
#define PG8_ALIGN true
#endif

namespace pg8 {
__device__ __forceinline__ float sigm(float x) { return __builtin_amdgcn_rcpf(1.0f + __expf(-x)); }
struct EpiGate1 {
    static constexpr bool PERM = true, AFTER_DRAIN = false;
    float* T; const bf16_t* z; int gcol;
    __device__ __forceinline__ void operator()(const f32x4 (&acc)[2][2][4][2], const Unit& u, int wr, int wc, int fr, int fq) const {
        const int row0 = u.pm * BM + wr * 64 + fr, col0 = u.pn * BM + wc * 32 + 8 * fq;
#pragma unroll
        for (int ai = 0; ai < 2; ++ai)
#pragma unroll
            for (int m = 0; m < 4; ++m) { const size_t r = (size_t)(row0 + ai * HALF + m * 16);
#pragma unroll
                for (int bj = 0; bj < 2; ++bj) { const int c = col0 + bj * HALF;
                    const u32x4 g = *(const u32x4*)(z + r * ZP + gcol + c);
                    const f32x4 s0 = {sigm(bflo(g.x)), sigm(bfhi(g.x)), sigm(bflo(g.y)), sigm(bfhi(g.y))}, s1 = {sigm(bflo(g.z)), sigm(bfhi(g.z)), sigm(bflo(g.w)), sigm(bfhi(g.w))};
                    *(f32x4*)(T + r * DM + c) = acc[ai][bj][m][0] * s0; *(f32x4*)(T + r * DM + c + 4) = acc[ai][bj][m][1] * s1; } }
    }
};
struct EpiGate2 {
    static constexpr bool PERM = true, AFTER_DRAIN = false;
    const float* T; const bf16_t* z; int gcol; bf16_t* H;
    __device__ __forceinline__ void operator()(const f32x4 (&acc)[2][2][4][2], const Unit& u, int wr, int wc, int fr, int fq) const {
        const int row0 = u.pm * BM + wr * 64 + fr, col0 = u.pn * BM + wc * 32 + 8 * fq;
#pragma unroll
        for (int ai = 0; ai < 2; ++ai)
#pragma unroll
            for (int m = 0; m < 4; ++m) { const size_t r = (size_t)(row0 + ai * HALF + m * 16);
#pragma unroll
                for (int bj = 0; bj < 2; ++bj) { const int c = col0 + bj * HALF;
                    const u32x4 g = *(const u32x4*)(z + r * ZP + gcol + c);
                    const f32x4 s0 = {sigm(bflo(g.x)), sigm(bfhi(g.x)), sigm(bflo(g.y)), sigm(bfhi(g.y))}, s1 = {sigm(bflo(g.z)), sigm(bfhi(g.z)), sigm(bflo(g.w)), sigm(bfhi(g.w))};
                    const f32x4 v0 = *(const f32x4*)(T + r * DM + c) + acc[ai][bj][m][0] * s0, v1 = *(const f32x4*)(T + r * DM + c + 4) + acc[ai][bj][m][1] * s1;
                    u32x4 w; w.x = cvt_pk_bf16(v0[0], v0[1]); w.y = cvt_pk_bf16(v0[2], v0[3]); w.z = cvt_pk_bf16(v1[0], v1[1]); w.w = cvt_pk_bf16(v1[2], v1[3]);
                    *(u32x4*)(H + r * DM + c) = w; } }
    }
};
struct EpiRes {
    static constexpr bool PERM = false, AFTER_DRAIN = false;
    float* C; const float* X; const float* bias;
    __device__ __forceinline__ void operator()(const f32x4 (&acc)[2][2][4][2], const Unit& u, int wr, int wc, int fr, int fq) const {
        const int row0 = u.pm * BM + wr * 64 + fr, col0 = u.pn * BM + wc * 32 + 4 * fq;
        f32x4 bv[2][2];
#pragma unroll
        for (int bj = 0; bj < 2; ++bj)
#pragma unroll
            for (int n = 0; n < 2; ++n) bv[bj][n] = *(const f32x4*)(bias + col0 + bj * HALF + n * 16);
#pragma unroll
        for (int ai = 0; ai < 2; ++ai)
#pragma unroll
            for (int m = 0; m < 4; ++m) { const size_t off = (size_t)(row0 + ai * HALF + m * 16) * DM + col0;
#pragma unroll
                for (int bj = 0; bj < 2; ++bj)
#pragma unroll
                    for (int n = 0; n < 2; ++n) *(f32x4*)(C + off + bj * HALF + n * 16) = *(const f32x4*)(X + off + bj * HALF + n * 16) * ALPHA + acc[ai][bj][m][n] + bv[bj][n]; }
    }
};
struct EpiZ2 {
    static constexpr bool PERM = true, AFTER_DRAIN = false;
    bf16_t* Z; bf16_t* U; const float* bias;
    __device__ __forceinline__ void operator()(const f32x4 (&acc)[2][2][4][2], const Unit& u, int wr, int wc, int fr, int fq) const {
        const int row0 = u.pm * BM + wr * 64 + fr;
        if (u.pn < 4) {
            const int ch0 = u.pn * 128 + wc * 32 + 8 * fq;
            f32x4 bv[2], bg[2];
#pragma unroll
            for (int n = 0; n < 2; ++n) { bv[n] = *(const f32x4*)(bias + O_CVAL + ch0 + 4 * n); bg[n] = *(const f32x4*)(bias + O_CGLU + ch0 + 4 * n); }
#pragma unroll
            for (int ai = 0; ai < 2; ++ai)
#pragma unroll
                for (int m = 0; m < 4; ++m) { const size_t r = (size_t)(row0 + ai * HALF + m * 16);
                    f32x4 v[2];
#pragma unroll
                    for (int n = 0; n < 2; ++n) { const f32x4 a = acc[ai][0][m][n] + bv[n], g = acc[ai][1][m][n] + bg[n];
                        v[n] = (f32x4){a[0] * sigm(g[0]), a[1] * sigm(g[1]), a[2] * sigm(g[2]), a[3] * sigm(g[3])}; }
                    u32x4 w; w.x = cvt_pk_bf16(v[0][0], v[0][1]); w.y = cvt_pk_bf16(v[0][2], v[0][3]); w.z = cvt_pk_bf16(v[1][0], v[1][1]); w.w = cvt_pk_bf16(v[1][2], v[1][3]);
                    *(u32x4*)(U + r * DC + ch0) = w; }
        } else {
            const int d0 = u.pn * BM + wc * 32 + 8 * fq;
            const int zc0 = d0 - 1024;
            f32x4 bv[2][2];
#pragma unroll
            for (int bj = 0; bj < 2; ++bj)
#pragma unroll
                for (int n = 0; n < 2; ++n) bv[bj][n] = *(const f32x4*)(bias + src_col(d0 + bj * HALF) + 4 * n);
#pragma unroll
            for (int ai = 0; ai < 2; ++ai)
#pragma unroll
                for (int m = 0; m < 4; ++m) { bf16_t* rowp = Z + (size_t)(row0 + ai * HALF + m * 16) * ZP + zc0;
#pragma unroll
                    for (int bj = 0; bj < 2; ++bj) { const f32x4 v0 = acc[ai][bj][m][0] + bv[bj][0], v1 = acc[ai][bj][m][1] + bv[bj][1];
                        u32x4 w; w.x = cvt_pk_bf16(v0[0], v0[1]); w.y = cvt_pk_bf16(v0[2], v0[3]); w.z = cvt_pk_bf16(v1[0], v1[1]); w.w = cvt_pk_bf16(v1[2], v1[3]);
                        *(u32x4*)(rowp + bj * HALF) = w; } }
        }
    }
};
struct EpiVT {
    static constexpr bool PERM = true, AFTER_DRAIN = false;
    bf16_t* O; int ldc; const float* rbias;
    __device__ __forceinline__ void operator()(const f32x4 (&acc)[2][2][4][2], const Unit& u, int wr, int wc, int fr, int fq) const {
        const int row0 = u.pm * BM + wr * 64 + fr, col0 = u.pn * BM + wc * 32 + 8 * fq;
#pragma unroll
        for (int ai = 0; ai < 2; ++ai)
#pragma unroll
            for (int m = 0; m < 4; ++m) { const int r = row0 + ai * HALF + m * 16; const float bv = rbias[r]; bf16_t* rowp = O + (size_t)r * ldc + col0;
#pragma unroll
                for (int bj = 0; bj < 2; ++bj) { const f32x4 v0 = acc[ai][bj][m][0] + bv, v1 = acc[ai][bj][m][1] + bv;
                    u32x4 w; w.x = cvt_pk_bf16(v0[0], v0[1]); w.y = cvt_pk_bf16(v0[2], v0[3]); w.z = cvt_pk_bf16(v1[0], v1[1]); w.w = cvt_pk_bf16(v1[2], v1[3]);
                    *(u32x4*)(rowp + bj * HALF) = w; } }
    }
};
}

constexpr int CT = 32, CROWS = CT + CW - 1;
__device__ __forceinline__ void p_conv(const bf16_t* __restrict__ U, const bf16_t* __restrict__ z, const float* __restrict__ cw, const float* __restrict__ cb,
                                       const float* __restrict__ lng, const float* __restrict__ lnb, bf16_t* __restrict__ uc, LAS3 float* sm, int vcu, int G) {
    const int tid = opaque_tid(), lane = tid & 63, wave = __builtin_amdgcn_readfirstlane(tid >> 6);
    float w[CW];
#pragma unroll
    for (int j = 0; j < CW; ++j) w[j] = cw[j * DC + tid];
    const float bias = cb[tid];
    f32x4 lg[2], lb[2];
#pragma unroll
    for (int n = 0; n < 2; ++n) { lg[n] = *(const f32x4*)(lng + 8 * lane + 4 * n); lb[n] = *(const f32x4*)(lnb + 8 * lane + 4 * n); }
    for (int tile = vcu; tile < M / CT; tile += G) {
        const int t0 = tile * CT, s0 = t0 % SEQ;
#pragma unroll
        for (int ps = 0; ps < (CROWS + 7) / 8; ++ps) { const int p = ps * 8 + wave;
            if (p < CROWS) { f32x4 v0 = {0.f, 0.f, 0.f, 0.f}, v1 = {0.f, 0.f, 0.f, 0.f};
                if (s0 - (CW - 1) + p >= 0) { const u32x4 q = *(const u32x4*)(U + (size_t)(t0 - (CW - 1) + p) * DC + 8 * lane);
                    v0 = (f32x4){bflo(q.x), bfhi(q.x), bflo(q.y), bfhi(q.y)}; v1 = (f32x4){bflo(q.z), bfhi(q.z), bflo(q.w), bfhi(q.w)}; }
                *(LAS3 f32x4*)(sm + p * DC + 8 * lane) = v0; *(LAS3 f32x4*)(sm + p * DC + 8 * lane + 4) = v1; } }
        __syncthreads();
        float acc[CT];
#pragma unroll
        for (int i = 0; i < CT; ++i) acc[i] = bias;
#pragma unroll
        for (int p = 0; p < CROWS; ++p) { const float g = sm[p * DC + tid];
#pragma unroll
            for (int i = 0; i < CT; ++i) { const int j = p - i; if (j >= 0 && j < CW) acc[i] += w[j] * g; } }
        __syncthreads();
#pragma unroll
        for (int i = 0; i < CT; ++i) sm[i * DC + tid] = acc[i];
        __syncthreads();
#pragma unroll
        for (int k = 0; k < 4; ++k) { const int i = wave * 4 + k; const size_t tok = (size_t)(t0 + i);
            const f32x4 a0 = *(const LAS3 f32x4*)(sm + i * DC + 8 * lane), a1 = *(const LAS3 f32x4*)(sm + i * DC + 8 * lane + 4);
            const u32x4 gq = *(const u32x4*)(z + tok * ZP + Z_CGATE + 8 * lane);
            float s = (a0[0] + a0[1]) + (a0[2] + a0[3]) + (a1[0] + a1[1]) + (a1[2] + a1[3]);
#pragma unroll
            for (int o = 1; o < 64; o <<= 1) s += __shfl_xor(s, o);
            const float mean = s * (1.0f / DC);
            const f32x4 d0 = a0 - mean, d1 = a1 - mean;
            float q2 = (d0[0] * d0[0] + d0[1] * d0[1]) + (d0[2] * d0[2] + d0[3] * d0[3]) + (d1[0] * d1[0] + d1[1] * d1[1]) + (d1[2] * d1[2] + d1[3] * d1[3]);
#pragma unroll
            for (int o = 1; o < 64; o <<= 1) q2 += __shfl_xor(q2, o);
            const float rstd = 1.0f / sqrtf(q2 * (1.0f / DC) + LN_EPS);
            const f32x4 y0 = d0 * rstd * lg[0] + lb[0], y1 = d1 * rstd * lg[1] + lb[1];
            u32x4 o4;
            o4.x = pk2(siluf_(y0[0]) * siluf_(bflo(gq.x)), siluf_(y0[1]) * siluf_(bfhi(gq.x))); o4.y = pk2(siluf_(y0[2]) * siluf_(bflo(gq.y)), siluf_(y0[3]) * siluf_(bfhi(gq.y)));
            o4.z = pk2(siluf_(y1[0]) * siluf_(bflo(gq.z)), siluf_(y1[1]) * siluf_(bfhi(gq.z))); o4.w = pk2(siluf_(y1[2]) * siluf_(bflo(gq.w)), siluf_(y1[3]) * siluf_(bfhi(gq.w)));
            *(u32x4*)(uc + tok * DC + 8 * lane) = o4; }
        __syncthreads();
    }
}

typedef float f32x16 __attribute__((ext_vector_type(16)));
typedef float f32x2_t __attribute__((ext_vector_type(2))); typedef __bf16 bf16x2_t __attribute__((ext_vector_type(2)));
__device__ __forceinline__ unsigned cvtpk_s(float lo, float hi) { f32x2_t v = {lo, hi}; bf16x2_t b = __builtin_convertvector(v, bf16x2_t); return __builtin_bit_cast(unsigned, b); }
constexpr int TABN = 320;
constexpr float LOG2E = 1.4426950408889634f;
constexpr float C1 = 0.125f * LOG2E;
template <int ZP> __device__ __forceinline__ void p_attn(const bf16_t* __restrict__ z, const int oq, const int ok, const int oag, const bf16_t* __restrict__ vt, const float* __restrict__ relb,
                                                        bf16_t* __restrict__ og, PG8_LAS float* tab, int vcu, int G) {
    const int tid = opaque_tid();
    for (int i = tid; i < NH * TABN; i += 512) { const int hh_ = i / TABN, t = i % TABN; tab[i] = relb[hh_ * N_REL + (t < 256 ? t : 256)] * LOG2E; }
    __syncthreads();
    const int lane = tid & 63, wave = __builtin_amdgcn_readfirstlane(tid >> 6), l31 = lane & 31, hh = lane >> 5;
    const int pi = (l31 & 19) | ((l31 & 4) << 1) | ((l31 & 8) >> 1);
    for (int gw = vcu * 8 + wave; gw < BATCH * NH * 32; gw += G * 8) {
      const int bh = gw >> 5, b = bh >> 3, h = bh & 7;
      const PG8_LAS float* tabh = tab + h * TABN;
      const float c0l = tabh[256];
#pragma unroll 1
      for (int it = 0; it < 2; ++it) {
        const int n = it == 0 ? (gw & 31) : 63 - (gw & 31);
        const size_t tok0 = (size_t)b * SEQ + (size_t)n * CHUNK;
        const bf16_t* zq = z + tok0 * ZP + oq + h * HD;
        bf16x8 qf[2][4];
#pragma unroll
        for (int qt = 0; qt < 2; ++qt)
#pragma unroll
            for (int s = 0; s < 4; ++s) qf[qt][s] = *(const bf16x8*)(zq + (size_t)(qt * 32 + l31) * ZP + 16 * s + 8 * hh);
        f32x16 o[2][2];
#pragma unroll
        for (int dt = 0; dt < 2; ++dt)
#pragma unroll
            for (int qt = 0; qt < 2; ++qt)
#pragma unroll
                for (int r = 0; r < 16; ++r) o[dt][qt][r] = 0.f;
        float m_run[2] = {-1e30f, -1e30f}, l_run[2] = {0.f, 0.f};
        const int kc0 = n >= LEFT ? n - LEFT : 0;
#pragma unroll 1
        for (int kc = kc0; kc <= n; ++kc) {
            const int w = kc - n + LEFT;
            const size_t key0 = (size_t)b * SEQ + (size_t)kc * CHUNK;
            const bf16_t* zk = z + key0 * ZP + ok + h * HD;
            bf16x8 kf[2][4];
#pragma unroll
            for (int kt = 0; kt < 2; ++kt)
#pragma unroll
                for (int s = 0; s < 4; ++s) kf[kt][s] = *(const bf16x8*)(zk + (size_t)(kt * 32 + pi) * ZP + 16 * s + 8 * hh);
            u32x4 pw[2][2][2];
#pragma unroll
            for (int qt = 0; qt < 2; ++qt) {
                f32x16 sa[2];
#pragma unroll
                for (int kt = 0; kt < 2; ++kt) { f32x16 a;
#pragma unroll
                    for (int r = 0; r < 16; ++r) a[r] = 0.f;
#pragma unroll
                    for (int s = 0; s < 4; ++s) a = __builtin_amdgcn_mfma_f32_32x32x16_bf16(kf[kt][s], qf[qt][s], a, 0, 0, 0);
                    sa[kt] = a; }
                if (w <= 5) {
#pragma unroll
                    for (int kt = 0; kt < 2; ++kt)
#pragma unroll
                        for (int r = 0; r < 16; ++r) sa[kt][r] = sa[kt][r] * C1 + c0l;
                } else {
#pragma unroll
                    for (int kt = 0; kt < 2; ++kt) { const int base = qt * 32 + l31 + 128 - (w - LEFT) * CHUNK - kt * 32 - 8 * hh;
#pragma unroll
                        for (int r = 0; r < 16; ++r) sa[kt][r] = sa[kt][r] * C1 + tabh[base - (16 * (r >> 3) + (r & 7))]; }
                }
                float cm = fmaxf(sa[0][0], sa[1][0]);
#pragma unroll
                for (int r = 1; r < 16; ++r) cm = fmaxf(cm, fmaxf(sa[0][r], sa[1][r]));
                cm = fmaxf(cm, __shfl_xor(cm, 32));
                const float mn = fmaxf(m_run[qt], cm);
                const float alpha = __builtin_amdgcn_exp2f(m_run[qt] - mn);
                m_run[qt] = mn;
                float ps = 0.f;
#pragma unroll
                for (int kt = 0; kt < 2; ++kt) {
#pragma unroll
                    for (int r = 0; r < 16; ++r) { const float p = __builtin_amdgcn_exp2f(sa[kt][r] - mn); sa[kt][r] = p; ps += p; }
#pragma unroll
                    for (int s2 = 0; s2 < 2; ++s2) { u32x4 t4; t4.x = cvtpk_s(sa[kt][8 * s2 + 0], sa[kt][8 * s2 + 1]); t4.y = cvtpk_s(sa[kt][8 * s2 + 2], sa[kt][8 * s2 + 3]);
                        t4.z = cvtpk_s(sa[kt][8 * s2 + 4], sa[kt][8 * s2 + 5]); t4.w = cvtpk_s(sa[kt][8 * s2 + 6], sa[kt][8 * s2 + 7]); pw[qt][kt][s2] = t4; }
                }
                l_run[qt] = l_run[qt] * alpha + ps;
#pragma unroll
                for (int dt = 0; dt < 2; ++dt)
#pragma unroll
                    for (int r = 0; r < 16; ++r) o[dt][qt][r] *= alpha;
            }
            const bf16_t* vp = vt + (size_t)(h * HD + l31) * M + key0 + 8 * hh;
#pragma unroll
            for (int kt = 0; kt < 2; ++kt)
#pragma unroll
                for (int s2 = 0; s2 < 2; ++s2) {
                    bf16x8 vf[2];
#pragma unroll
                    for (int dt = 0; dt < 2; ++dt) vf[dt] = *(const bf16x8*)(vp + (size_t)(dt * 32) * M + kt * 32 + 16 * s2);
#pragma unroll
                    for (int qt = 0; qt < 2; ++qt) {
                        const bf16x8 pb = __builtin_bit_cast(bf16x8, pw[qt][kt][s2]);
#pragma unroll
                        for (int dt = 0; dt < 2; ++dt) o[dt][qt] = __builtin_amdgcn_mfma_f32_32x32x16_bf16(vf[dt], pb, o[dt][qt], 0, 0, 0);
                    }
                }
        }
#pragma unroll
        for (int qt = 0; qt < 2; ++qt) {
            const float lt = l_run[qt] + __shfl_xor(l_run[qt], 32);
            const float inv = 1.0f / lt;
            const size_t tok = tok0 + qt * 32 + l31;
            const bf16_t* gp = z + tok * ZP + oag + h * HD + 4 * hh;
            bf16_t* op = og + tok * DA + h * HD + 4 * hh;
#pragma unroll
            for (int dt = 0; dt < 2; ++dt)
#pragma unroll
                for (int g4 = 0; g4 < 4; ++g4) {
                    const uint2 gg = *(const uint2*)(gp + dt * 32 + 8 * g4);
                    const float v0 = o[dt][qt][4 * g4 + 0] * inv * siluf_(bflo(gg.x)), v1 = o[dt][qt][4 * g4 + 1] * inv * siluf_(bfhi(gg.x));
                    const float v2 = o[dt][qt][4 * g4 + 2] * inv * siluf_(bflo(gg.y)), v3 = o[dt][qt][4 * g4 + 3] * inv * siluf_(bfhi(gg.y));
                    uint2 ov; ov.x = cvtpk_s(v0, v1); ov.y = cvtpk_s(v2, v3);
                    *(uint2*)(op + dt * 32 + 8 * g4) = ov;
                }
        }
      }
    }
}

__device__ __forceinline__ void p_ln(float* __restrict__ out, const float* __restrict__ g, const float* __restrict__ bta) {
  const int tid_ = opaque_tid();
  for (int row = blockIdx.x * 8 + (tid_ >> 6); row < M; row += gridDim.x * 8) {
    const int lane = tid_ & 63;
    f32x4* p = (f32x4*)(out + (size_t)row * DM) + lane;
    f32x4 v[4]; float s = 0.f;
#pragma unroll
    for (int j = 0; j < 4; ++j) { v[j] = p[64 * j]; s += (v[j].x + v[j].y) + (v[j].z + v[j].w); }
#pragma unroll
    for (int o = 1; o < 64; o <<= 1) s += __shfl_xor(s, o);
    const float mean = s * (1.0f / DM); float s2 = 0.f;
#pragma unroll
    for (int j = 0; j < 4; ++j) { v[j] = v[j] - mean; s2 += (v[j].x * v[j].x + v[j].y * v[j].y) + (v[j].z * v[j].z + v[j].w * v[j].w); }
#pragma unroll
    for (int o = 1; o < 64; o <<= 1) s2 += __shfl_xor(s2, o);
    const float rstd = 1.0f / sqrtf(s2 * (1.0f / DM) + LN_EPS);
#pragma unroll
    for (int j = 0; j < 4; ++j) { const f32x4 gg = ((const f32x4*)g)[lane + 64 * j], bb = ((const f32x4*)bta)[lane + 64 * j]; p[64 * j] = v[j] * rstd * gg + bb; }
  }
}

constexpr int LDS_BYTES = 147456;
struct Params { const float* in[14]; float* out; unsigned char* ws; };
__global__ void __launch_bounds__(512, 2) fwd_megakernel(Params p) {
    cg::grid_group grid = cg::this_grid();
    extern __shared__ __attribute__((aligned(16))) unsigned char lds[];
    PG8_LAS unsigned char* ldsp = (PG8_LAS unsigned char*)lds;
    const float* x = p.in[0]; const float* w_in = p.in[1]; const float* b_in = p.in[2];
    const float* conv_w = p.in[3]; const float* conv_b = p.in[4]; const float* cln_g = p.in[5]; const float* cln_b = p.in[6];
    const float* w_co = p.in[7]; const float* relb = p.in[8]; const float* w_ao = p.in[9];
    const float* w_o = p.in[10]; const float* b_o = p.in[11]; const float* oln_g = p.in[12]; const float* oln_b = p.in[13];
    unsigned char* ws = p.ws; float* out = p.out;
    bf16_t* Win_t = (bf16_t*)(ws + WS_WIN); bf16_t* Wc_t = (bf16_t*)(ws + WS_WC); bf16_t* Wa_t = (bf16_t*)(ws + WS_WA); bf16_t* Wo_t = (bf16_t*)(ws + WS_WO);
    bf16_t* xb = (bf16_t*)(ws + WS_XB); bf16_t* hb = (bf16_t*)(ws + WS_H); bf16_t* z = (bf16_t*)(ws + WS_Z); bf16_t* uc = (bf16_t*)(ws + WS_UC); bf16_t* og = (bf16_t*)(ws + WS_OG); bf16_t* ub = (bf16_t*)(ws + WS_U); bf16_t* vt = (bf16_t*)(ws + WS_VT);
    const int G = (int)gridDim.x, bid = (int)blockIdx.x;
    const int vcu = (G % 8 == 0) ? (bid % 8) * (G / 8) + bid / 8 : bid;
    p_cvt(x, xb, (size_t)M * DM / 8);
    p_weights(w_in, w_co, w_ao, w_o, Win_t, Wc_t, Wa_t, Wo_t, ldsp, vcu * 8 + (int)(threadIdx.x >> 6), G * 8);
    grid.sync();
    { pg8::Gemm g{xb, Win_t, M, N1, DM}; pg8::StaticOrder S; S.init(M, N1, G, bid);
      pg8::EpiZ2 E{z, ub, b_in};
      pg8::gemm_phase<pg8::EpiZ2, pg8::StaticOrder, PG8_ALIGN, PG8_SP2>(ldsp, g, S, E); }
    { pg8::Gemm g{Win_t + (size_t)N1 * DM, xb, DA, M, DM}; pg8::StaticOrder S; S.init(DA, M, G, bid);
      pg8::EpiVT E{vt, M, b_in + O_V};
      pg8::gemm_phase<pg8::EpiVT, pg8::StaticOrder, PG8_ALIGN, PG8_SP2>(ldsp, g, S, E); }
    grid.sync();
    p_conv(ub, z, conv_w, conv_b, cln_g, cln_b, uc, (LAS3 float*)ldsp, vcu, G);
    p_attn<ZP>(z, Z_Q, Z_K, Z_AG, vt, relb, og, (PG8_LAS float*)ldsp, vcu, G);
    grid.sync();
    { pg8::Gemm g{uc, Wc_t, M, DM, DC}; pg8::StaticOrder S; S.init(M, DM, G, bid);
      pg8::EpiGate1 E{out, z, Z_GC};
      pg8::gemm_phase<pg8::EpiGate1, pg8::StaticOrder, PG8_ALIGN, PG8_SP2>(ldsp, g, S, E); }
    { pg8::Gemm g{og, Wa_t, M, DM, DA}; pg8::StaticOrder S; S.init(M, DM, G, bid);
      pg8::EpiGate2 E{out, z, Z_GA, hb};
      pg8::gemm_phase<pg8::EpiGate2, pg8::StaticOrder, PG8_ALIGN, PG8_SP2>(ldsp, g, S, E); }
    grid.sync();
    { pg8::Gemm g{hb, Wo_t, M, DM, DM}; pg8::StaticOrder S; S.init(M, DM, G, bid);
      pg8::EpiRes E{out, x, b_o};
      pg8::gemm_phase<pg8::EpiRes, pg8::StaticOrder, PG8_ALIGN, PG8_SP2>(ldsp, g, S, E); }
    grid.sync();
    p_ln(out, oln_g, oln_b);
}

extern "C" void kernel_launch(void* const* d_in, const int* in_sizes, int n_in, void* d_out, int out_size, void* d_ws, size_t ws_size, hipStream_t stream) {
    if (n_in != 14 || in_sizes[0] != M * DM || out_size != M * DM || ws_size < WS_END) { fprintf(stderr, "kernel_launch: unexpected shapes / workspace (n_in %d, ws %zu)\n", n_in, ws_size); return; }
    static int grid_blocks = 0;
    if (!grid_blocks) {
        int dev = 0, cus = 0, per_cu = 0;
        (void)hipGetDevice(&dev);
        (void)hipDeviceGetAttribute(&cus, hipDeviceAttributeMultiprocessorCount, dev);
        if (hipFuncSetAttribute((const void*)fwd_megakernel, hipFuncAttributeMaxDynamicSharedMemorySize, LDS_BYTES) != hipSuccess) fprintf(stderr, "kernel_launch: hipFuncSetAttribute failed\n");
        (void)hipOccupancyMaxActiveBlocksPerMultiprocessor(&per_cu, fwd_megakernel, 512, LDS_BYTES);
        if (per_cu < 1) { fprintf(stderr, "kernel_launch: occupancy query returned %d\n", per_cu); }
        grid_blocks = cus;
    }
    Params p{};
    for (int i = 0; i < 14; ++i) p.in[i] = (const float*)d_in[i];
    p.out = (float*)d_out; p.ws = (unsigned char*)d_ws;
    void* args[] = {&p};
    hipError_t e = hipLaunchCooperativeKernel((void*)fwd_megakernel, dim3(grid_blocks), dim3(512), args, LDS_BYTES, stream);
    if (e != hipSuccess) fprintf(stderr, "cooperative launch failed: %s (grid %d)\n", hipGetErrorString(e), grid_blocks);
}
```

```cpp
#include <hip/hip_runtime.h>
#include <hip/hip_cooperative_groups.h>
namespace cg = cooperative_groups;
#include <cstdio>
#include <cstdint>

typedef unsigned short bf16_t;
typedef short bf16x8 __attribute__((ext_vector_type(8)));
typedef float f32x4 __attribute__((ext_vector_type(4)));
typedef unsigned u32x4 __attribute__((ext_vector_type(4)));

constexpr int BATCH = 8, SEQ = 4096, DM = 1024, M = BATCH * SEQ;
constexpr int DC = 512, DA = 512, NH = 8, HD = 64, CW = 31, DIN = 5632, CHUNK = 64, NCH = SEQ / CHUNK, LEFT = 8;
constexpr int MAX_REL = 128, N_REL = 257;
constexpr int O_CVAL = 0, O_CGLU = 512, O_CGATE = 1024, O_Q = 1536, O_K = 2048, O_V = 2560, O_AG = 3072, O_GC = 3584, O_GA = 4608;
__host__ __device__ __forceinline__ int src_col(int d) { if (d < 1024) { const int t = d >> 8, j = d & 255; return j < 128 ? 128 * t + j : 512 + 128 * t + (j - 128); } return d < 2560 ? d : (d < 5120 ? d + 512 : d - 2560); }
constexpr int ZP = 4096, Z_CGATE = 0, Z_Q = 512, Z_K = 1024, Z_AG = 1536, Z_GC = 2048, Z_GA = 3072, N1 = 5120;
constexpr float LN_EPS = 1e-5f;
constexpr float ALPHA = 1.189207115002721f;

constexpr size_t MiB = 1u << 20;
constexpr size_t WS_WIN = 2 * MiB, WS_WC = 14 * MiB, WS_WA = 15 * MiB, WS_WO = 16 * MiB;
constexpr size_t WS_XB = 32 * MiB;
constexpr size_t WS_H = 32 * MiB;
constexpr size_t WS_Z = 96 * MiB;
constexpr size_t WS_U = 352 * MiB;
constexpr size_t WS_VT = 384 * MiB;
constexpr size_t WS_UC = 416 * MiB;
constexpr size_t WS_OG = 448 * MiB;
constexpr size_t WS_END = 480 * MiB;

__device__ __forceinline__ unsigned f2bf(float f) { unsigned u = __builtin_bit_cast(unsigned, f); return (u + 0x7fffu + ((u >> 16) & 1u)) >> 16; }
__device__ __forceinline__ unsigned pk2(float lo, float hi) { return f2bf(lo) | (f2bf(hi) << 16); }
__device__ __forceinline__ float bf2f(bf16_t b) { return __uint_as_float(((unsigned)b) << 16); }
__device__ __forceinline__ float bflo(unsigned w) { return __uint_as_float(w << 16); }
__device__ __forceinline__ float bfhi(unsigned w) { return __uint_as_float(w & 0xffff0000u); }
__device__ __forceinline__ float sigmoidf_(float x) { return 1.0f / (1.0f + __expf(-x)); }
__device__ __forceinline__ float siluf_(float x) { return x / (1.0f + __expf(-x)); }

__device__ __forceinline__ int opaque_tid() { int t = (int)threadIdx.x; asm volatile("" : "+v"(t)); return t; }
__device__ __forceinline__ void p_cvt(const float* __restrict__ x, bf16_t* __restrict__ xb, size_t n8) {
    for (size_t i = (size_t)blockIdx.x * blockDim.x + opaque_tid(); i < n8; i += (size_t)gridDim.x * blockDim.x) {
        const f32x4 a = ((const f32x4*)x)[2 * i], b = ((const f32x4*)x)[2 * i + 1];
        u32x4 o; o.x = pk2(a.x, a.y); o.y = pk2(a.z, a.w); o.z = pk2(b.x, b.y); o.w = pk2(b.z, b.w);
        ((u32x4*)xb)[i] = o;
    }
}
#define LAS3 __attribute__((address_space(3)))
__device__ __forceinline__ void transpose_item(const float* __restrict__ W, int K, int N, bf16_t* __restrict__ WT, int k0, int n0src, int n0dst, LAS3 float* scr, int lane) {
#pragma unroll 8
    for (int i = 0; i < 32; ++i) { const int kk = 2 * i + (lane >> 5); scr[kk * 33 + (lane & 31)] = W[(size_t)(k0 + kk) * N + n0src + (lane & 31)]; }
    asm volatile("s_waitcnt lgkmcnt(0)" ::: "memory");
    const int c = lane & 7;
#pragma unroll
    for (int j = 0; j < 4; ++j) { const int n = (lane >> 3) + 8 * j; const LAS3 float* s = scr + (8 * c) * 33 + n;
        u32x4 o; o.x = pk2(s[0 * 33], s[1 * 33]); o.y = pk2(s[2 * 33], s[3 * 33]); o.z = pk2(s[4 * 33], s[5 * 33]); o.w = pk2(s[6 * 33], s[7 * 33]);
        *(u32x4*)(WT + (size_t)(n0dst + n) * K + k0 + 8 * c) = o; }
    asm volatile("s_waitcnt lgkmcnt(0)" ::: "memory");
}
__device__ __forceinline__ void p_weights(const float* w_in, const float* w_co, const float* w_ao, const float* w_o, bf16_t* Win_t, bf16_t* Wc_t, bf16_t* Wa_t, bf16_t* Wo_t, LAS3 unsigned char* lds, int gw, int NGW) {
    const int tid = opaque_tid(), lane = tid & 63, wave = __builtin_amdgcn_readfirstlane(tid >> 6);
    LAS3 float* scr = (LAS3 float*)(lds + wave * 16384);
    constexpr int I_IN = (DM / 64) * (DIN / 32), I_C = (DC / 64) * (DM / 32), I_O = (DM / 64) * (DM / 32), NITEMS = I_IN + 2 * I_C + I_O;
    for (int it = gw; it < NITEMS; it += NGW) {
        int r = it;
        if (r < I_IN) { const int nb = r % (DIN / 32), kb = r / (DIN / 32); transpose_item(w_in, DM, DIN, Win_t, 64 * kb, src_col(32 * nb), 32 * nb, scr, lane); continue; } r -= I_IN;
        if (r < I_C) { const int nb = r % (DM / 32), kb = r / (DM / 32); transpose_item(w_co, DC, DM, Wc_t, 64 * kb, 32 * nb, 32 * nb, scr, lane); continue; } r -= I_C;
        if (r < I_C) { const int nb = r % (DM / 32), kb = r / (DM / 32); transpose_item(w_ao, DA, DM, Wa_t, 64 * kb, 32 * nb, 32 * nb, scr, lane); continue; } r -= I_C;
        { const int nb = r % (DM / 32), kb = r / (DM / 32); transpose_item(w_o, DM, DM, Wo_t, 64 * kb, 32 * nb, 32 * nb, scr, lane); }
    }
}

namespace pg8 {
#define PG8_LAS __attribute__((address_space(3)))
typedef unsigned short bf16_t;
typedef short bf16x8 __attribute__((ext_vector_type(8)));
typedef float f32x4 __attribute__((ext_vector_type(4)));
typedef unsigned u32x4 __attribute__((ext_vector_type(4)));
constexpr int BM = 256, BK = 64, HALF = 128, HTB = HALF * BK * 2  , STAGE_BYTES = 8 * HTB, NXCD = 8, WGM = 8;

__host__ __device__ __forceinline__ int lds_byte(int r, int c) { const int st = (r >> 4) * 2 + (c >> 5), rr = r & 15, cc = c & 31, ob = rr * 64 + cc * 2; return st * 1024 + (ob ^ (((ob >> 9) & 1) << 5)); }
__host__ __device__ __forceinline__ void stage_rc(int b, int& R, int& C) { const int st = b / 1024, sb = b % 1024, swz = sb ^ (((sb >> 9) & 1) << 5); R = (st >> 1) * 16 + swz / 64; C = (st & 1) * 32 + (swz % 64) / 2; }
__host__ __device__ __forceinline__ int perm32(int rho) { const int n = rho >> 4, i = rho & 15; return 8 * (i >> 2) + 4 * n + (i & 3); }

struct Unit { int pm, pn, seg; };
struct Gemm { const bf16_t* A; const bf16_t* Bt; int M, N, K; const bf16_t* A2; const bf16_t* Bt2; };

struct StaticOrder {
    int nM, nN, nwg, G, c;
    __host__ __device__ void init(int M, int N, int G_, int c_) { nM = M / BM; nN = N / BM; nwg = nM * nN; G = G_; c = c_; }
    __host__ __device__ bool next(int i, Unit& u) const {
        const long L = (long)i * G + c; if (L >= nwg) return false;
        int wgid = (int)L; { const int q = nwg / NXCD, r = nwg % NXCD, xcd = wgid % NXCD, off = wgid / NXCD; wgid = (xcd < r ? xcd * (q + 1) : r * (q + 1) + (xcd - r) * q) + off; }
        const int nig = WGM * nN, gid = wgid / nig, fm = gid * WGM, gsz = (nM - fm) < WGM ? (nM - fm) : WGM;
        u.pm = fm + ((wgid % nig) % gsz); u.pn = (wgid % nig) / gsz; u.seg = 0; return true;
    }
    __device__ __forceinline__ void a_ready(const Unit&) const {}
    __device__ __forceinline__ void done(const Unit&) const {}
};

__device__ __forceinline__ unsigned cvt_pk_bf16(float lo, float hi) { unsigned r; asm volatile("v_cvt_pk_bf16_f32 %0, %1, %2" : "=v"(r) : "v"(lo), "v"(hi)); return r; }
typedef float f32x2 __attribute__((ext_vector_type(2)));
__device__ __forceinline__ f32x2 gelu_pk(f32x2 v) {
    const f32x2 av = __builtin_elementwise_abs(v), d = av * 0.2316418882f + 1.0f;
    f32x2 t; t.x = __builtin_amdgcn_rcpf(d.x); t.y = __builtin_amdgcn_rcpf(d.y);
    f32x2 q = t * 0.5307027145f + (-0.7265760135f); q = q * t + 0.7107068705f; q = q * t + (-0.142248368f); q = q * t + 0.127414796f; q = q * t;
    const f32x2 s = (v * v) * (-0.72134752044f);
    f32x2 e; e.x = __builtin_amdgcn_exp2f(s.x); e.y = __builtin_amdgcn_exp2f(s.y);
    const f32x2 m = v * (q * e), r = v - m;
    f32x2 o; o.x = v.x < 0.f ? m.x : r.x; o.y = v.y < 0.f ? m.y : r.y; return o;
}

template <int ACT  > struct EpiBf16 {
    static constexpr bool PERM = true, AFTER_DRAIN = false, TWO_SEG = false; static_assert(ACT == 0 || ACT == 1, "EpiBf16: ACT is 0 (none) or 1 (gelu_pk)");
    bf16_t* O; int ldc; const float* bias; int split_cols; size_t split_stride; float scale0;
    __device__ __forceinline__ void operator()(const f32x4 (&acc)[2][2][4][2], const Unit& u, int wr, int wc, int fr, int fq) const {
        const int row0 = u.pm * BM + wr * 64 + fr; int colt = u.pn * BM; bf16_t* base = O;
        float sc = 1.f; if (split_cols) { const int t = colt / split_cols; base += (size_t)t * split_stride; colt -= t * split_cols; if (t == 0) sc = scale0; }
        const int col0 = colt + wc * 32 + 8 * fq, bcol0 = u.pn * BM + wc * 32 + 8 * fq;
        f32x4 bv[2][2];
#pragma unroll
        for (int bj = 0; bj < 2; ++bj)
#pragma unroll
            for (int n = 0; n < 2; ++n) bv[bj][n] = bias ? *(const f32x4*)(bias + bcol0 + bj * HALF + 4 * n) : (f32x4){0.f, 0.f, 0.f, 0.f};
#pragma unroll
        for (int ai = 0; ai < 2; ++ai)
#pragma unroll
            for (int m = 0; m < 4; ++m) { bf16_t* rowp = base + (size_t)(row0 + ai * HALF + m * 16) * ldc + col0;
#pragma unroll
                for (int bj = 0; bj < 2; ++bj) { f32x4 v0 = acc[ai][bj][m][0] + bv[bj][0], v1 = acc[ai][bj][m][1] + bv[bj][1];
                    if (ACT == 1) { f32x2 a = gelu_pk((f32x2){v0[0], v0[1]}), b = gelu_pk((f32x2){v0[2], v0[3]}), c = gelu_pk((f32x2){v1[0], v1[1]}), d = gelu_pk((f32x2){v1[2], v1[3]});
                        v0 = (f32x4){a.x, a.y, b.x, b.y}; v1 = (f32x4){c.x, c.y, d.x, d.y}; }
                    v0 = v0 * sc; v1 = v1 * sc; u32x4 w; w.x = cvt_pk_bf16(v0[0], v0[1]); w.y = cvt_pk_bf16(v0[2], v0[3]); w.z = cvt_pk_bf16(v1[0], v1[1]); w.w = cvt_pk_bf16(v1[2], v1[3]);
                    *(u32x4*)(rowp + bj * HALF) = w; } }
    }
};

struct PanelStats {
    unsigned* xbuf;
    unsigned* cnt;
    unsigned* tmo;
    int ntn; float eps;
    unsigned code;
    __device__ __forceinline__ bool run(const f32x4 (&v)[2][2][4][2], const Unit& u, int wr, int wc, int fr, int fq, PG8_LAS unsigned char* lds, int wid, int lane) const {
        typedef float f32x2v __attribute__((ext_vector_type(2)));
        PG8_LAS f32x2v* P = (PG8_LAS f32x2v*)lds;
        PG8_LAS f32x2v* S = (PG8_LAS f32x2v*)(lds + 8192);
        PG8_LAS unsigned* flag = (PG8_LAS unsigned*)(lds + 8192 + 2048);
#pragma unroll
        for (int ai = 0; ai < 2; ++ai)
#pragma unroll
            for (int m = 0; m < 4; ++m) {
                float s = 0.f;
#pragma unroll
                for (int bj = 0; bj < 2; ++bj)
#pragma unroll
                    for (int n = 0; n < 2; ++n) { const f32x4 x = v[ai][bj][m][n]; s += (x[0] + x[1]) + (x[2] + x[3]); }
                s += __shfl_xor(s, 16); s += __shfl_xor(s, 32);
                const float mw = s * (1.0f / 64.0f); float q = 0.f;
#pragma unroll
                for (int bj = 0; bj < 2; ++bj)
#pragma unroll
                    for (int n = 0; n < 2; ++n) { const f32x4 d = v[ai][bj][m][n] - mw; q += (d[0] * d[0] + d[1] * d[1]) + (d[2] * d[2] + d[3] * d[3]); }
                q += __shfl_xor(q, 16); q += __shfl_xor(q, 32);
                if (fq == 0) P[(ai * HALF + wr * 64 + m * 16 + fr) * 4 + wc] = (f32x2v){mw, q};
            }
        asm volatile("s_waitcnt lgkmcnt(0)" ::: "memory"); __builtin_amdgcn_s_barrier(); asm volatile("" ::: "memory");
#if defined(BROKEN_EXCHANGE_NO_WAIT)
#warning BROKEN CONTROL BUILD: the row-statistics exchange does not wait; results are wrong by design
        if (blockIdx.x >= 64) { const long long t0_ = clock64(); while (clock64() - t0_ < 60000) __builtin_amdgcn_s_sleep(8); }
#endif
        const int row = wid * 32 + (lane & 31);
        if (lane < 32) {
            const f32x2v a = P[row * 4 + 0], b = P[row * 4 + 1], c = P[row * 4 + 2], d = P[row * 4 + 3];
            const float mt = (a.x + b.x + c.x + d.x) * 0.25f;
            const float da = a.x - mt, db = b.x - mt, dc = c.x - mt, dd = d.x - mt;
            const float m2 = (a.y + b.y) + (c.y + d.y) + 64.0f * ((da * da + db * db) + (dc * dc + dd * dd));
            unsigned long long* slot = (unsigned long long*)xbuf + ((size_t)(u.pm * BM + row) * 4 + u.pn);
            __hip_atomic_store(slot, ((unsigned long long)__float_as_uint(m2) << 32) | __float_as_uint(mt), __ATOMIC_RELAXED, __HIP_MEMORY_SCOPE_AGENT);
        }
        asm volatile("s_waitcnt vmcnt(0)" ::: "memory");
        if (lane == 0) __hip_atomic_fetch_add(cnt + 64 * u.pm, 1u, __ATOMIC_RELAXED, __HIP_MEMORY_SCOPE_AGENT);
        if (wid == 0) {
            bool dead = false; const unsigned long long t0 = __builtin_amdgcn_s_memrealtime(); const unsigned want = 8u * (unsigned)ntn;
            for (;;) {
#if defined(BROKEN_EXCHANGE_NO_WAIT)
                break;
#endif
                if ((unsigned)__builtin_amdgcn_readfirstlane(__hip_atomic_load(cnt + 64 * u.pm, __ATOMIC_RELAXED, __HIP_MEMORY_SCOPE_AGENT)) >= want) break;
                if (__builtin_amdgcn_s_memrealtime() - t0 > 2000000ull) {
                    if (lane == 0) { unsigned expect = 0u; __hip_atomic_compare_exchange_strong(tmo + 1, &expect, code | (unsigned)(u.pm & 0xff), __ATOMIC_RELAXED, __ATOMIC_RELAXED, __HIP_MEMORY_SCOPE_AGENT);
                                     __hip_atomic_store(tmo, 1u, __ATOMIC_RELAXED, __HIP_MEMORY_SCOPE_AGENT); }
                    dead = true; break; }
                __builtin_amdgcn_s_sleep(2);
            }
            __builtin_amdgcn_fence(__ATOMIC_ACQUIRE, "agent");
            if (lane == 0) flag[0] = dead ? 1u : 0u;
        }
        asm volatile("s_waitcnt vmcnt(0) lgkmcnt(0)" ::: "memory"); __builtin_amdgcn_s_barrier(); asm volatile("" ::: "memory");
        const bool bad = flag[0] != 0u;
        if (lane < 32) {
            const unsigned long long* slot = (const unsigned long long*)xbuf + (size_t)(u.pm * BM + row) * 4; float mt[4], m2[4]; float ms = 0.f;
#pragma unroll
            for (int t = 0; t < 4; ++t) { if (t < ntn) { const unsigned long long w = __hip_atomic_load(slot + t, __ATOMIC_RELAXED, __HIP_MEMORY_SCOPE_AGENT); mt[t] = __uint_as_float((unsigned)w); m2[t] = __uint_as_float((unsigned)(w >> 32)); } else { mt[t] = 0.f; m2[t] = 0.f; } ms += mt[t]; }
            const float mean = ms / (float)ntn; float q = 0.f;
#pragma unroll
            for (int t = 0; t < 4; ++t) if (t < ntn) { const float dm = mt[t] - mean; q += m2[t] + 256.0f * dm * dm; }
            S[row] = (f32x2v){mean, 1.0f / sqrtf(q / (256.0f * (float)ntn) + eps)};
        }
        asm volatile("s_waitcnt lgkmcnt(0)" ::: "memory"); __builtin_amdgcn_s_barrier(); asm volatile("" ::: "memory");
        return bad;
    }
};
struct EpiLnRes {
    static constexpr bool PERM = false, AFTER_DRAIN = true, TWO_SEG = false;
    const float* base; float* out; int ldc; const float* bias; PanelStats st; unsigned poison;
    __device__ __forceinline__ void fused(f32x4 (&acc)[2][2][4][2], const Unit& u, int wr, int wc, int fr, int fq, PG8_LAS unsigned char* lds, int wid, int lane) const {
        typedef float f32x2v __attribute__((ext_vector_type(2)));
        const PG8_LAS f32x2v* S = (const PG8_LAS f32x2v*)(lds + 8192);
        const int col0 = u.pn * BM + wc * 32 + 4 * fq;
#pragma unroll
        for (int bj = 0; bj < 2; ++bj)
#pragma unroll
            for (int n = 0; n < 2; ++n) { const f32x4 bv = bias ? *(const f32x4*)(bias + col0 + bj * HALF + n * 16) : (f32x4){0.f, 0.f, 0.f, 0.f};
#pragma unroll
                for (int ai = 0; ai < 2; ++ai)
#pragma unroll
                    for (int m = 0; m < 4; ++m) acc[ai][bj][m][n] += bv; }
        f32x4 pre[4][2][2];
#pragma unroll
        for (int m = 0; m < 4; ++m) { const size_t off = (size_t)(u.pm * BM + wr * 64 + m * 16 + fr) * ldc + col0;
#pragma unroll
            for (int bj = 0; bj < 2; ++bj)
#pragma unroll
                for (int n = 0; n < 2; ++n) pre[m][bj][n] = *(const f32x4*)(base + off + bj * HALF + n * 16); }
        const bool bad = st.run(acc, u, wr, wc, fr, fq, lds, wid, lane) || poison != 0u;
        const float qnan = __builtin_nanf("");
#pragma unroll
        for (int ai = 0; ai < 2; ++ai)
#pragma unroll
            for (int m = 0; m < 4; ++m) { const int r = ai * HALF + wr * 64 + m * 16 + fr; const f32x2v sr = S[r]; const size_t off = (size_t)(u.pm * BM + r) * ldc + col0;
#pragma unroll
                for (int bj = 0; bj < 2; ++bj)
#pragma unroll
                    for (int n = 0; n < 2; ++n) { const f32x4 bs = ai == 0 ? pre[m][bj][n] : *(const f32x4*)(base + off + bj * HALF + n * 16); f32x4 o = bs + (acc[ai][bj][m][n] - sr.x) * sr.y;
                        if (bad) o = (f32x4){qnan, qnan, qnan, qnan}; *(f32x4*)(out + off + bj * HALF + n * 16) = o; }
                if (m & 1) asm volatile("" ::: "memory"); }
    }
};
struct EpiLnResLn {
    static constexpr bool PERM = false, AFTER_DRAIN = true, TWO_SEG = false;
    const float* base; float* out; bf16_t* xn; int ldc; const float* bias; PanelStats st1, st2; unsigned poison;
    __device__ __forceinline__ void fused(f32x4 (&acc)[2][2][4][2], const Unit& u, int wr, int wc, int fr, int fq, PG8_LAS unsigned char* lds, int wid, int lane) const {
        typedef float f32x2v __attribute__((ext_vector_type(2))); typedef unsigned u32x2v __attribute__((ext_vector_type(2)));
        const PG8_LAS f32x2v* S = (const PG8_LAS f32x2v*)(lds + 8192);
        const int col0 = u.pn * BM + wc * 32 + 4 * fq;
#pragma unroll
        for (int bj = 0; bj < 2; ++bj)
#pragma unroll
            for (int n = 0; n < 2; ++n) { const f32x4 bv = bias ? *(const f32x4*)(bias + col0 + bj * HALF + n * 16) : (f32x4){0.f, 0.f, 0.f, 0.f};
#pragma unroll
                for (int ai = 0; ai < 2; ++ai)
#pragma unroll
                    for (int m = 0; m < 4; ++m) acc[ai][bj][m][n] += bv; }
        bool bad = st1.run(acc, u, wr, wc, fr, fq, lds, wid, lane) || poison != 0u;
        const float qnan = __builtin_nanf("");
#pragma unroll
        for (int ai = 0; ai < 2; ++ai)
#pragma unroll
            for (int m = 0; m < 4; ++m) { const int r = ai * HALF + wr * 64 + m * 16 + fr; const f32x2v sr = S[r]; const size_t off = (size_t)(u.pm * BM + r) * ldc + col0;
#pragma unroll
                for (int bj = 0; bj < 2; ++bj)
#pragma unroll
                    for (int n = 0; n < 2; ++n) { const f32x4 bs = *(const f32x4*)(base + off + bj * HALF + n * 16); acc[ai][bj][m][n] = bs + (acc[ai][bj][m][n] - sr.x) * sr.y; }
                asm volatile("" : "+v"(acc[ai][0][m][0]), "+v"(acc[ai][0][m][1]), "+v"(acc[ai][1][m][0]), "+v"(acc[ai][1][m][1]));
                if (m & 1) asm volatile("" ::: "memory"); }
        const bool bad1 = bad;
        bad = st2.run(acc, u, wr, wc, fr, fq, lds, wid, lane) || bad;
#pragma unroll
        for (int ai = 0; ai < 2; ++ai)
#pragma unroll
            for (int m = 0; m < 4; ++m) { const int r = ai * HALF + wr * 64 + m * 16 + fr; const f32x2v sr = S[r]; const size_t off = (size_t)(u.pm * BM + r) * ldc + col0;
#pragma unroll
                for (int bj = 0; bj < 2; ++bj)
#pragma unroll
                    for (int n = 0; n < 2; ++n) { const f32x4 x1 = acc[ai][bj][m][n]; *(f32x4*)(out + off + bj * HALF + n * 16) = bad1 ? (f32x4){qnan, qnan, qnan, qnan} : x1;
                        const f32x4 o = (x1 - sr.x) * sr.y; u32x2v w; w.x = cvt_pk_bf16(o[0], o[1]); w.y = cvt_pk_bf16(o[2], o[3]);
                        if (bad) { w.x = 0x7fc07fc0u; w.y = 0x7fc07fc0u; } *(u32x2v*)(xn + off + bj * HALF + n * 16) = w; }
                asm volatile("" ::: "memory"); }
    }
};

template <class Epi, class Sched, bool ALIGN_EPI = false, bool SP2 = false>
__device__ __forceinline__ void gemm_phase(PG8_LAS unsigned char* lds, const Gemm g, const Sched& S, const Epi& E) {
    const int tid = opaque_tid(), wid = __builtin_amdgcn_readfirstlane(tid >> 6), lane = tid & 63, wr = wid >> 2, wc = wid & 3, fr = lane & 15, fq = lane >> 4;
    const int K = g.K, nt = K / BK;
    unsigned voffA[2], voffB[2];
#pragma unroll
    for (int i = 0; i < 2; ++i) { int R, C; stage_rc(tid * 16 + i * 8192, R, C); const int Rb = Epi::PERM ? ((R & ~31) + perm32(R & 31)) : R;
        voffA[i] = (unsigned)(R * K + C) * 2u; voffB[i] = (unsigned)(Rb * K + C) * 2u; }
    const size_t kstep = (size_t)(BK * 2);
    const size_t hstep = (size_t)HALF * K * 2;
    const size_t tstep = 2 * hstep;
    const unsigned ldsw = (unsigned)wid * 1024u;
    const int aoff = lds_byte(wr * 64 + fr, fq * 8), boff = lds_byte(wc * 32 + fr, fq * 8);
#define PG8_SA(b, h) (((b) * 2 + (h)) * HTB)
#define PG8_SB(b, h) ((4 + (b) * 2 + (h)) * HTB)
#define PG8_STAGE(bufoff, gbase, voff) do { _Pragma("unroll") for (int _i = 0; _i < 2; ++_i) \
        __builtin_amdgcn_global_load_lds((const unsigned*)((const char*)(gbase) + (voff)[_i]), (PG8_LAS unsigned*)(lds + (bufoff) + ldsw + _i * 8192), 16, 0, 0); } while (0)
#define PG8_LDA(dst, b, h) do { _Pragma("unroll") for (int m = 0; m < 4; ++m) _Pragma("unroll") for (int k = 0; k < 2; ++k) dst[m][k] = *(const PG8_LAS bf16x8*)(lds + PG8_SA(b, h) + aoff + m * 2048 + k * 1024); } while (0)
#define PG8_LDB(dst, b, h) do { _Pragma("unroll") for (int n = 0; n < 2; ++n) _Pragma("unroll") for (int k = 0; k < 2; ++k) dst[n][k] = *(const PG8_LAS bf16x8*)(lds + PG8_SB(b, h) + boff + n * 2048 + k * 1024); } while (0)
#define PG8_MMA(ai, bj, At, Bt) do { __builtin_amdgcn_s_setprio(1); _Pragma("unroll") for (int m = 0; m < 4; ++m) _Pragma("unroll") for (int n = 0; n < 2; ++n) _Pragma("unroll") for (int k = 0; k < 2; ++k) \
        acc[ai][bj][m][n] = __builtin_amdgcn_mfma_f32_16x16x32_bf16(Bt[n][k], At[m][k], acc[ai][bj][m][n], 0, 0, 0); __builtin_amdgcn_s_setprio(0); } while (0)
#define PG8_WAIT_V(n) asm volatile("s_waitcnt vmcnt(" #n ")" ::: "memory")
#define PG8_WAIT_L(n) asm volatile("s_waitcnt lgkmcnt(" #n ")" ::: "memory")
#define PG8_BAR __builtin_amdgcn_s_barrier()
#define PG8_SCHED __builtin_amdgcn_sched_barrier(0)
    Unit cur, nxt; int ui = 0;
    if (!S.next(0, cur)) return;
    f32x4 acc[2][2][4][2];
#pragma unroll
    for (int a = 0; a < 2; ++a)
#pragma unroll
        for (int b = 0; b < 2; ++b)
#pragma unroll
            for (int m = 0; m < 4; ++m)
#pragma unroll
                for (int n = 0; n < 2; ++n) acc[a][b][m][n] = (f32x4){0.f, 0.f, 0.f, 0.f};
    bf16x8 At[4][2], B0[2][2], B1[2][2];
    const char* cA = (const char*)((Epi::TWO_SEG && cur.seg) ? g.A2 : g.A) + (size_t)cur.pm * tstep; const char* cB = (const char*)((Epi::TWO_SEG && cur.seg) ? g.Bt2 : g.Bt) + (size_t)cur.pn * tstep;
    S.a_ready(cur);
    if constexpr (SP2) {
        PG8_STAGE(PG8_SB(0, 0), cB, voffB); PG8_STAGE(PG8_SB(0, 1), cB + hstep, voffB); PG8_STAGE(PG8_SA(0, 0), cA, voffA); PG8_STAGE(PG8_SA(0, 1), cA + hstep, voffA);
        if (wr == 1) PG8_BAR;
        PG8_WAIT_V(2); PG8_BAR;
        PG8_STAGE(PG8_SB(1, 0), cB + kstep, voffB); PG8_STAGE(PG8_SA(1, 0), cA + kstep, voffA); PG8_STAGE(PG8_SB(1, 1), cB + hstep + kstep, voffB);
        PG8_WAIT_V(6); PG8_BAR;
    } else {
        PG8_STAGE(PG8_SB(0, 0), cB, voffB); PG8_STAGE(PG8_SA(0, 0), cA, voffA); PG8_STAGE(PG8_SB(0, 1), cB + hstep, voffB); PG8_STAGE(PG8_SA(0, 1), cA + hstep, voffA);
        if (wr == 1) PG8_BAR;
        PG8_WAIT_V(4); PG8_BAR;
        PG8_STAGE(PG8_SB(1, 0), cB + kstep, voffB); PG8_STAGE(PG8_SA(1, 0), cA + kstep, voffA); PG8_STAGE(PG8_SB(1, 1), cB + hstep + kstep, voffB);
        PG8_WAIT_V(6); PG8_BAR;
    }
    for (;;) {
        const bool has_next = S.next(ui + 1, nxt);
        const char* nA = has_next ? (const char*)((Epi::TWO_SEG && nxt.seg) ? g.A2 : g.A) + (size_t)nxt.pm * tstep : cA; const char* nB = has_next ? (const char*)((Epi::TWO_SEG && nxt.seg) ? g.Bt2 : g.Bt) + (size_t)nxt.pn * tstep : cB;
        for (int t = 0; t < nt; t += 2) {
            const bool last = (t == nt - 2);
            const char* a1 = cA + (size_t)(t + 1) * kstep;
            const char* a2 = last ? nA : cA + (size_t)(t + 2) * kstep; const char* b2 = last ? nB : cB + (size_t)(t + 2) * kstep;
            const char* a3 = a2 + kstep; const char* b3 = b2 + kstep;
            if (last && has_next) S.a_ready(nxt);
            if constexpr (SP2) {
            PG8_LDB(B0, 0, 0); PG8_LDB(B1, 0, 1); PG8_SCHED; PG8_LDA(At, 0, 0); PG8_STAGE(PG8_SA(1, 1), a1 + hstep, voffA);
            PG8_WAIT_V(8); PG8_WAIT_L(0); PG8_BAR; PG8_MMA(0, 0, At, B0); PG8_MMA(0, 1, At, B1); PG8_BAR; PG8_SCHED;
            PG8_LDA(At, 0, 1); PG8_STAGE(PG8_SB(0, 0), b2, voffB); PG8_STAGE(PG8_SB(0, 1), b2 + hstep, voffB); PG8_STAGE(PG8_SA(0, 0), a2, voffA);
            PG8_WAIT_V(8); PG8_WAIT_L(0); PG8_BAR; PG8_MMA(1, 0, At, B0); PG8_MMA(1, 1, At, B1); PG8_BAR; PG8_SCHED;
            PG8_LDB(B0, 1, 0); PG8_LDB(B1, 1, 1); PG8_SCHED; PG8_LDA(At, 1, 0); PG8_STAGE(PG8_SA(0, 1), a2 + hstep, voffA);
            PG8_WAIT_V(8); PG8_WAIT_L(0); PG8_BAR; PG8_MMA(0, 0, At, B0); PG8_MMA(0, 1, At, B1); PG8_BAR; PG8_SCHED;
            PG8_LDA(At, 1, 1); PG8_STAGE(PG8_SB(1, 0), b3, voffB); PG8_STAGE(PG8_SB(1, 1), b3 + hstep, voffB); PG8_STAGE(PG8_SA(1, 0), a3, voffA);
            PG8_WAIT_V(8); PG8_WAIT_L(0); PG8_BAR; PG8_MMA(1, 0, At, B0); PG8_MMA(1, 1, At, B1); PG8_BAR; PG8_SCHED;
            } else {
            PG8_LDB(B0, 0, 0); PG8_SCHED; PG8_LDA(At, 0, 0); PG8_STAGE(PG8_SA(1, 1), a1 + hstep, voffA);
            PG8_WAIT_L(8); PG8_BAR; PG8_WAIT_L(0); PG8_MMA(0, 0, At, B0); PG8_BAR; PG8_SCHED;
            PG8_LDB(B1, 0, 1); PG8_STAGE(PG8_SB(0, 0), b2, voffB);
            PG8_BAR; PG8_WAIT_L(0); PG8_MMA(0, 1, At, B1); PG8_BAR;
            PG8_LDA(At, 0, 1); PG8_STAGE(PG8_SA(0, 0), a2, voffA);
            PG8_BAR; PG8_WAIT_L(0); PG8_MMA(1, 0, At, B0); PG8_BAR; PG8_SCHED;
            PG8_STAGE(PG8_SB(0, 1), b2 + hstep, voffB);
            PG8_WAIT_V(6); PG8_BAR; PG8_MMA(1, 1, At, B1); PG8_BAR;
            PG8_LDB(B0, 1, 0); PG8_SCHED; PG8_LDA(At, 1, 0); PG8_STAGE(PG8_SA(0, 1), a2 + hstep, voffA);
            PG8_WAIT_L(8); PG8_BAR; PG8_WAIT_L(0); PG8_MMA(0, 0, At, B0); PG8_BAR; PG8_SCHED;
            PG8_LDB(B1, 1, 1); PG8_STAGE(PG8_SB(1, 0), b3, voffB);
            PG8_BAR; PG8_WAIT_L(0); PG8_MMA(0, 1, At, B1); PG8_BAR;
            PG8_LDA(At, 1, 1); PG8_STAGE(PG8_SA(1, 0), a3, voffA);
            PG8_BAR; PG8_WAIT_L(0); PG8_MMA(1, 0, At, B0); PG8_BAR; PG8_SCHED;
            PG8_STAGE(PG8_SB(1, 1), b3 + hstep, voffB);
            PG8_WAIT_V(6); PG8_BAR; PG8_MMA(1, 1, At, B1); PG8_BAR;
            }
        }
        if constexpr (ALIGN_EPI) { if (wr == 0) PG8_BAR; }
        if constexpr (Epi::TWO_SEG) { if (cur.seg == 0) E.mid(acc, cur, wr, wc, fr, fq); else { E(acc, cur, wr, wc, fr, fq); S.done(cur); } }
        else if constexpr (!Epi::AFTER_DRAIN) { E(acc, cur, wr, wc, fr, fq); S.done(cur); }
        if (!has_next) break;
        if (!(Epi::TWO_SEG && cur.seg == 0))
#pragma unroll
        for (int a = 0; a < 2; ++a)
#pragma unroll
            for (int b = 0; b < 2; ++b)
#pragma unroll
                for (int m = 0; m < 4; ++m)
#pragma unroll
                    for (int n = 0; n < 2; ++n) acc[a][b][m][n] = (f32x4){0.f, 0.f, 0.f, 0.f};
        cur = nxt; cA = nA; cB = nB; ++ui;
        if constexpr (ALIGN_EPI) { if (wr == 1) PG8_BAR; }
    }
    PG8_WAIT_V(0);
    if constexpr (!ALIGN_EPI) { if (wr == 0) PG8_BAR; }
    PG8_BAR;
    if constexpr (Epi::AFTER_DRAIN) { E.fused(acc, cur, wr, wc, fr, fq, lds, wid, lane); S.done(cur); }
#undef PG8_SA
#undef PG8_SB
#undef PG8_STAGE
#undef PG8_LDA
#undef PG8_LDB
#undef PG8_MMA
#undef PG8_WAIT_V
#undef PG8_WAIT_L
#undef PG8_BAR
#undef PG8_SCHED
}
}

#ifndef PG8_SP2
#define PG8_SP2 true
#endif
#ifndef PG8_ALIGN
#define PG8_ALIGN true
#endif

namespace pg8 {
__device__ __forceinline__ float sigm(float x) { return __builtin_amdgcn_rcpf(1.0f + __expf(-x)); }
struct EpiGate1 {
    static constexpr bool PERM = true, AFTER_DRAIN = false, TWO_SEG = false;
    float* T; const bf16_t* z; int gcol;
    __device__ __forceinline__ void operator()(const f32x4 (&acc)[2][2][4][2], const Unit& u, int wr, int wc, int fr, int fq) const {
        const int row0 = u.pm * BM + wr * 64 + fr, col0 = u.pn * BM + wc * 32 + 8 * fq;
#pragma unroll
        for (int ai = 0; ai < 2; ++ai)
#pragma unroll
            for (int m = 0; m < 4; ++m) { const size_t r = (size_t)(row0 + ai * HALF + m * 16);
#pragma unroll
                for (int bj = 0; bj < 2; ++bj) { const int c = col0 + bj * HALF;
                    const u32x4 g = *(const u32x4*)(z + r * ZP + gcol + c);
                    const f32x4 s0 = {sigm(bflo(g.x)), sigm(bfhi(g.x)), sigm(bflo(g.y)), sigm(bfhi(g.y))}, s1 = {sigm(bflo(g.z)), sigm(bfhi(g.z)), sigm(bflo(g.w)), sigm(bfhi(g.w))};
                    *(f32x4*)(T + r * DM + c) = acc[ai][bj][m][0] * s0; *(f32x4*)(T + r * DM + c + 4) = acc[ai][bj][m][1] * s1; } }
    }
};
struct EpiGate2 {
    static constexpr bool PERM = true, AFTER_DRAIN = false, TWO_SEG = false;
    const float* T; const bf16_t* z; int gcol; bf16_t* H;
    __device__ __forceinline__ void operator()(const f32x4 (&acc)[2][2][4][2], const Unit& u, int wr, int wc, int fr, int fq) const {
        const int row0 = u.pm * BM + wr * 64 + fr, col0 = u.pn * BM + wc * 32 + 8 * fq;
#pragma unroll
        for (int ai = 0; ai < 2; ++ai)
#pragma unroll
            for (int m = 0; m < 4; ++m) { const size_t r = (size_t)(row0 + ai * HALF + m * 16);
#pragma unroll
                for (int bj = 0; bj < 2; ++bj) { const int c = col0 + bj * HALF;
                    const u32x4 g = *(const u32x4*)(z + r * ZP + gcol + c);
                    const f32x4 s0 = {sigm(bflo(g.x)), sigm(bfhi(g.x)), sigm(bflo(g.y)), sigm(bfhi(g.y))}, s1 = {sigm(bflo(g.z)), sigm(bfhi(g.z)), sigm(bflo(g.w)), sigm(bfhi(g.w))};
                    const f32x4 v0 = *(const f32x4*)(T + r * DM + c) + acc[ai][bj][m][0] * s0, v1 = *(const f32x4*)(T + r * DM + c + 4) + acc[ai][bj][m][1] * s1;
                    u32x4 w; w.x = cvt_pk_bf16(v0[0], v0[1]); w.y = cvt_pk_bf16(v0[2], v0[3]); w.z = cvt_pk_bf16(v1[0], v1[1]); w.w = cvt_pk_bf16(v1[2], v1[3]);
                    *(u32x4*)(H + r * DM + c) = w; } }
    }
};
struct EpiRes {
    static constexpr bool PERM = false, AFTER_DRAIN = false, TWO_SEG = false;
    float* C; const float* X; const float* bias;
    __device__ __forceinline__ void operator()(const f32x4 (&acc)[2][2][4][2], const Unit& u, int wr, int wc, int fr, int fq) const {
        const int row0 = u.pm * BM + wr * 64 + fr, col0 = u.pn * BM + wc * 32 + 4 * fq;
        f32x4 bv[2][2];
#pragma unroll
        for (int bj = 0; bj < 2; ++bj)
#pragma unroll
            for (int n = 0; n < 2; ++n) bv[bj][n] = *(const f32x4*)(bias + col0 + bj * HALF + n * 16);
#pragma unroll
        for (int ai = 0; ai < 2; ++ai)
#pragma unroll
            for (int m = 0; m < 4; ++m) { const size_t off = (size_t)(row0 + ai * HALF + m * 16) * DM + col0;
#pragma unroll
                for (int bj = 0; bj < 2; ++bj)
#pragma unroll
                    for (int n = 0; n < 2; ++n) *(f32x4*)(C + off + bj * HALF + n * 16) = *(const f32x4*)(X + off + bj * HALF + n * 16) * ALPHA + acc[ai][bj][m][n] + bv[bj][n]; }
    }
};
struct EpiZ2 {
    static constexpr bool PERM = true, AFTER_DRAIN = false, TWO_SEG = false;
    bf16_t* Z; bf16_t* U; const float* bias;
    __device__ __forceinline__ void operator()(const f32x4 (&acc)[2][2][4][2], const Unit& u, int wr, int wc, int fr, int fq) const {
        const int row0 = u.pm * BM + wr * 64 + fr;
        if (u.pn < 4) {
            const int ch0 = u.pn * 128 + wc * 32 + 8 * fq;
            f32x4 bv[2], bg[2];
#pragma unroll
            for (int n = 0; n < 2; ++n) { bv[n] = *(const f32x4*)(bias + O_CVAL + ch0 + 4 * n); bg[n] = *(const f32x4*)(bias + O_CGLU + ch0 + 4 * n); }
#pragma unroll
            for (int ai = 0; ai < 2; ++ai)
#pragma unroll
                for (int m = 0; m < 4; ++m) { const size_t r = (size_t)(row0 + ai * HALF + m * 16);
                    f32x4 v[2];
#pragma unroll
                    for (int n = 0; n < 2; ++n) { const f32x4 a = acc[ai][0][m][n] + bv[n], g = acc[ai][1][m][n] + bg[n];
                        v[n] = (f32x4){a[0] * sigm(g[0]), a[1] * sigm(g[1]), a[2] * sigm(g[2]), a[3] * sigm(g[3])}; }
                    u32x4 w; w.x = cvt_pk_bf16(v[0][0], v[0][1]); w.y = cvt_pk_bf16(v[0][2], v[0][3]); w.z = cvt_pk_bf16(v[1][0], v[1][1]); w.w = cvt_pk_bf16(v[1][2], v[1][3]);
                    *(u32x4*)(U + r * DC + ch0) = w; }
        } else {
            const int d0 = u.pn * BM + wc * 32 + 8 * fq;
            const int zc0 = d0 - 1024;
            f32x4 bv[2][2];
#pragma unroll
            for (int bj = 0; bj < 2; ++bj)
#pragma unroll
                for (int n = 0; n < 2; ++n) bv[bj][n] = *(const f32x4*)(bias + src_col(d0 + bj * HALF) + 4 * n);
#pragma unroll
            for (int ai = 0; ai < 2; ++ai)
#pragma unroll
                for (int m = 0; m < 4; ++m) { bf16_t* rowp = Z + (size_t)(row0 + ai * HALF + m * 16) * ZP + zc0;
#pragma unroll
                    for (int bj = 0; bj < 2; ++bj) { const f32x4 v0 = acc[ai][bj][m][0] + bv[bj][0], v1 = acc[ai][bj][m][1] + bv[bj][1];
                        u32x4 w; w.x = cvt_pk_bf16(v0[0], v0[1]); w.y = cvt_pk_bf16(v0[2], v0[3]); w.z = cvt_pk_bf16(v1[0], v1[1]); w.w = cvt_pk_bf16(v1[2], v1[3]);
                        *(u32x4*)(rowp + bj * HALF) = w; } }
        }
    }
};
struct StaticOrder2 : StaticOrder {
    __host__ __device__ bool next(int i, Unit& u) const { if (!StaticOrder::next(i >> 1, u)) return false; u.seg = i & 1; return true; }
};
struct EpiMerge {
    static constexpr bool PERM = true, AFTER_DRAIN = false, TWO_SEG = true;
    const bf16_t* z; bf16_t* H;
    static __device__ __forceinline__ float ex(float g) { return __expf(fminf(-g, 30.0f)); }
    __device__ __forceinline__ void mid(f32x4 (&acc)[2][2][4][2], const Unit& u, int wr, int wc, int fr, int fq) const {
        const int row0 = u.pm * BM + wr * 64 + fr, col0 = u.pn * BM + wc * 32 + 8 * fq;
#pragma unroll
        for (int ai = 0; ai < 2; ++ai)
#pragma unroll
            for (int m = 0; m < 4; ++m) { const size_t r = (size_t)(row0 + ai * HALF + m * 16);
#pragma unroll
                for (int bj = 0; bj < 2; ++bj) { const int c = col0 + bj * HALF;
                    const u32x4 g1 = *(const u32x4*)(z + r * ZP + Z_GC + c), g2 = *(const u32x4*)(z + r * ZP + Z_GA + c);
                    const f32x4 e1a = {ex(bflo(g1.x)), ex(bfhi(g1.x)), ex(bflo(g1.y)), ex(bfhi(g1.y))}, e1b = {ex(bflo(g1.z)), ex(bfhi(g1.z)), ex(bflo(g1.w)), ex(bfhi(g1.w))};
                    const f32x4 e2a = {ex(bflo(g2.x)), ex(bfhi(g2.x)), ex(bflo(g2.y)), ex(bfhi(g2.y))}, e2b = {ex(bflo(g2.z)), ex(bfhi(g2.z)), ex(bflo(g2.w)), ex(bfhi(g2.w))};
                    const f32x4 ra = {(1.f + e2a[0]) * __builtin_amdgcn_rcpf(1.f + e1a[0]), (1.f + e2a[1]) * __builtin_amdgcn_rcpf(1.f + e1a[1]), (1.f + e2a[2]) * __builtin_amdgcn_rcpf(1.f + e1a[2]), (1.f + e2a[3]) * __builtin_amdgcn_rcpf(1.f + e1a[3])};
                    const f32x4 rb = {(1.f + e2b[0]) * __builtin_amdgcn_rcpf(1.f + e1b[0]), (1.f + e2b[1]) * __builtin_amdgcn_rcpf(1.f + e1b[1]), (1.f + e2b[2]) * __builtin_amdgcn_rcpf(1.f + e1b[2]), (1.f + e2b[3]) * __builtin_amdgcn_rcpf(1.f + e1b[3])};
                    acc[ai][bj][m][0] *= ra; acc[ai][bj][m][1] *= rb; } }
    }
    __device__ __forceinline__ void operator()(const f32x4 (&acc)[2][2][4][2], const Unit& u, int wr, int wc, int fr, int fq) const {
        const int row0 = u.pm * BM + wr * 64 + fr, col0 = u.pn * BM + wc * 32 + 8 * fq;
#pragma unroll
        for (int ai = 0; ai < 2; ++ai)
#pragma unroll
            for (int m = 0; m < 4; ++m) { const size_t r = (size_t)(row0 + ai * HALF + m * 16);
#pragma unroll
                for (int bj = 0; bj < 2; ++bj) { const int c = col0 + bj * HALF;
                    const u32x4 g2 = *(const u32x4*)(z + r * ZP + Z_GA + c);
                    const f32x4 sa = {__builtin_amdgcn_rcpf(1.f + ex(bflo(g2.x))), __builtin_amdgcn_rcpf(1.f + ex(bfhi(g2.x))), __builtin_amdgcn_rcpf(1.f + ex(bflo(g2.y))), __builtin_amdgcn_rcpf(1.f + ex(bfhi(g2.y)))};
                    const f32x4 sb = {__builtin_amdgcn_rcpf(1.f + ex(bflo(g2.z))), __builtin_amdgcn_rcpf(1.f + ex(bfhi(g2.z))), __builtin_amdgcn_rcpf(1.f + ex(bflo(g2.w))), __builtin_amdgcn_rcpf(1.f + ex(bfhi(g2.w)))};
                    const f32x4 v0 = acc[ai][bj][m][0] * sa, v1 = acc[ai][bj][m][1] * sb;
                    u32x4 w; w.x = cvt_pk_bf16(v0[0], v0[1]); w.y = cvt_pk_bf16(v0[2], v0[3]); w.z = cvt_pk_bf16(v1[0], v1[1]); w.w = cvt_pk_bf16(v1[2], v1[3]);
                    *(u32x4*)(H + r * DM + c) = w; } }
    }
};
struct EpiVT {
    static constexpr bool PERM = true, AFTER_DRAIN = false, TWO_SEG = false;
    bf16_t* O; int ldc; const float* rbias;
    __device__ __forceinline__ void operator()(const f32x4 (&acc)[2][2][4][2], const Unit& u, int wr, int wc, int fr, int fq) const {
        const int row0 = u.pm * BM + wr * 64 + fr, col0 = u.pn * BM + wc * 32 + 8 * fq;
#pragma unroll
        for (int ai = 0; ai < 2; ++ai)
#pragma unroll
            for (int m = 0; m < 4; ++m) { const int r = row0 + ai * HALF + m * 16; const float bv = rbias[r]; bf16_t* rowp = O + (size_t)r * ldc + col0;
#pragma unroll
                for (int bj = 0; bj < 2; ++bj) { const f32x4 v0 = acc[ai][bj][m][0] + bv, v1 = acc[ai][bj][m][1] + bv;
                    u32x4 w; w.x = cvt_pk_bf16(v0[0], v0[1]); w.y = cvt_pk_bf16(v0[2], v0[3]); w.z = cvt_pk_bf16(v1[0], v1[1]); w.w = cvt_pk_bf16(v1[2], v1[3]);
                    *(u32x4*)(rowp + bj * HALF) = w; } }
    }
};
}

constexpr int CT = 32, CROWS = CT + CW - 1, CBLK = 8, CGB = CBLK + CW - 1, CONV_OUT_OFF = 65536;
__device__ __forceinline__ void p_conv(const bf16_t* __restrict__ U, const bf16_t* __restrict__ z, const float* __restrict__ cw, const float* __restrict__ cb,
                                       const float* __restrict__ lng, const float* __restrict__ lnb, bf16_t* __restrict__ uc, LAS3 unsigned char* lds, int vcu, int G) {
    const int tid = opaque_tid(), lane = tid & 63, wave = __builtin_amdgcn_readfirstlane(tid >> 6);
    LAS3 bf16_t* stg = (LAS3 bf16_t*)lds; LAS3 float* outb = (LAS3 float*)(lds + CONV_OUT_OFF);
    float w[CW];
#pragma unroll
    for (int j = 0; j < CW; ++j) w[j] = cw[j * DC + tid];
    const float bias = cb[tid];
    f32x4 lg[2], lb[2];
#pragma unroll
    for (int n = 0; n < 2; ++n) { lg[n] = *(const f32x4*)(lng + 8 * lane + 4 * n); lb[n] = *(const f32x4*)(lnb + 8 * lane + 4 * n); }
    for (int tile = vcu; tile < M / CT; tile += G) {
        const int t0 = tile * CT, s0 = t0 % SEQ;
#pragma unroll
        for (int ps = 0; ps < (CROWS + 7) / 8; ++ps) { const int p = ps * 8 + wave;
            if (p < CROWS) { u32x4 q = {0u, 0u, 0u, 0u};
                if (s0 - (CW - 1) + p >= 0) q = *(const u32x4*)(U + (size_t)(t0 - (CW - 1) + p) * DC + 8 * lane);
                *(LAS3 u32x4*)(stg + p * DC + 8 * lane) = q; } }
        __syncthreads();
#pragma unroll 1
        for (int blk = 0; blk < CT / CBLK; ++blk) {
            float g[CGB];
#pragma unroll
            for (int p = 0; p < CGB; ++p) g[p] = bf2f(stg[(blk * CBLK + p) * DC + tid]);
            float acc[CBLK];
#pragma unroll
            for (int i = 0; i < CBLK; ++i) acc[i] = bias;
#pragma unroll
            for (int j = 0; j < CW; ++j)
#pragma unroll
                for (int i = 0; i < CBLK; ++i) acc[i] += w[j] * g[i + j];
#pragma unroll
            for (int i = 0; i < CBLK; ++i) outb[(blk * CBLK + i) * DC + tid] = acc[i];
        }
        __syncthreads();
#pragma unroll
        for (int k = 0; k < 4; ++k) { const int i = wave * 4 + k; const size_t tok = (size_t)(t0 + i);
            const f32x4 a0 = *(const LAS3 f32x4*)(outb + i * DC + 8 * lane), a1 = *(const LAS3 f32x4*)(outb + i * DC + 8 * lane + 4);
            const u32x4 gq = *(const u32x4*)(z + tok * ZP + Z_CGATE + 8 * lane);
            float s = (a0[0] + a0[1]) + (a0[2] + a0[3]) + (a1[0] + a1[1]) + (a1[2] + a1[3]);
#pragma unroll
            for (int o = 1; o < 64; o <<= 1) s += __shfl_xor(s, o);
            const float mean = s * (1.0f / DC);
            const f32x4 d0 = a0 - mean, d1 = a1 - mean;
            float q2 = (d0[0] * d0[0] + d0[1] * d0[1]) + (d0[2] * d0[2] + d0[3] * d0[3]) + (d1[0] * d1[0] + d1[1] * d1[1]) + (d1[2] * d1[2] + d1[3] * d1[3]);
#pragma unroll
            for (int o = 1; o < 64; o <<= 1) q2 += __shfl_xor(q2, o);
            const float rstd = __builtin_amdgcn_rsqf(q2 * (1.0f / DC) + LN_EPS);
            const f32x4 y0 = d0 * rstd * lg[0] + lb[0], y1 = d1 * rstd * lg[1] + lb[1];
            u32x4 o4;
            o4.x = pk2(siluf_(y0[0]) * siluf_(bflo(gq.x)), siluf_(y0[1]) * siluf_(bfhi(gq.x))); o4.y = pk2(siluf_(y0[2]) * siluf_(bflo(gq.y)), siluf_(y0[3]) * siluf_(bfhi(gq.y)));
            o4.z = pk2(siluf_(y1[0]) * siluf_(bflo(gq.z)), siluf_(y1[1]) * siluf_(bfhi(gq.z))); o4.w = pk2(siluf_(y1[2]) * siluf_(bflo(gq.w)), siluf_(y1[3]) * siluf_(bfhi(gq.w)));
            *(u32x4*)(uc + tok * DC + 8 * lane) = o4; }
        __syncthreads();
    }
}

typedef float f32x16 __attribute__((ext_vector_type(16)));
typedef float f32x2_t __attribute__((ext_vector_type(2))); typedef __bf16 bf16x2_t __attribute__((ext_vector_type(2)));
__device__ __forceinline__ unsigned cvtpk_s(float lo, float hi) { f32x2_t v = {lo, hi}; bf16x2_t b = __builtin_convertvector(v, bf16x2_t); return __builtin_bit_cast(unsigned, b); }
constexpr int TABN = 320;
constexpr float LOG2E = 1.4426950408889634f;
constexpr float C1 = 0.125f * LOG2E;
template <int ZP> __device__ __forceinline__ void p_attn(const bf16_t* __restrict__ z, const int oq, const int ok, const int oag, const bf16_t* __restrict__ vt, const float* __restrict__ relb,
                                                        bf16_t* __restrict__ og, PG8_LAS float* tab, int vcu, int G) {
    const int tid = opaque_tid();
    for (int i = tid; i < NH * TABN; i += 512) { const int hh_ = i / TABN, t = i % TABN; tab[i] = relb[hh_ * N_REL + (t < 256 ? t : 256)] * LOG2E; }
    __syncthreads();
    const int lane = tid & 63, wave = __builtin_amdgcn_readfirstlane(tid >> 6), l31 = lane & 31, hh = lane >> 5;
    const int pi = (l31 & 19) | ((l31 & 4) << 1) | ((l31 & 8) >> 1);
    for (int gw = vcu * 8 + wave; gw < BATCH * NH * 32; gw += G * 8) {
      const int bh = gw >> 5, b = bh >> 3, h = bh & 7;
      const PG8_LAS float* tabh = tab + h * TABN;
      const float c0l = tabh[256];
#pragma unroll 1
      for (int it = 0; it < 2; ++it) {
        const int n = it == 0 ? (gw & 31) : 63 - (gw & 31);
        const size_t tok0 = (size_t)b * SEQ + (size_t)n * CHUNK;
        const bf16_t* zq = z + tok0 * ZP + oq + h * HD;
        bf16x8 qf[2][4];
#pragma unroll
        for (int qt = 0; qt < 2; ++qt)
#pragma unroll
            for (int s = 0; s < 4; ++s) qf[qt][s] = *(const bf16x8*)(zq + (size_t)(qt * 32 + l31) * ZP + 16 * s + 8 * hh);
        f32x16 o[2][2];
#pragma unroll
        for (int dt = 0; dt < 2; ++dt)
#pragma unroll
            for (int qt = 0; qt < 2; ++qt)
#pragma unroll
                for (int r = 0; r < 16; ++r) o[dt][qt][r] = 0.f;
        float m_run[2] = {-1e30f, -1e30f}, l_run[2] = {0.f, 0.f};
        const int kc0 = n >= LEFT ? n - LEFT : 0;
#pragma unroll 1
        for (int kc = kc0; kc <= n; ++kc) {
            const int w = kc - n + LEFT;
            const size_t key0 = (size_t)b * SEQ + (size_t)kc * CHUNK;
            const bf16_t* zk = z + key0 * ZP + ok + h * HD;
            bf16x8 kf[2][4];
#pragma unroll
            for (int kt = 0; kt < 2; ++kt)
#pragma unroll
                for (int s = 0; s < 4; ++s) kf[kt][s] = *(const bf16x8*)(zk + (size_t)(kt * 32 + pi) * ZP + 16 * s + 8 * hh);
            u32x4 pw[2][2][2];
#pragma unroll
            for (int qt = 0; qt < 2; ++qt) {
                f32x16 sa[2];
#pragma unroll
                for (int kt = 0; kt < 2; ++kt) { f32x16 a;
#pragma unroll
                    for (int r = 0; r < 16; ++r) a[r] = 0.f;
#pragma unroll
                    for (int s = 0; s < 4; ++s) a = __builtin_amdgcn_mfma_f32_32x32x16_bf16(kf[kt][s], qf[qt][s], a, 0, 0, 0);
                    sa[kt] = a; }
                if (w <= 5) {
#pragma unroll
                    for (int kt = 0; kt < 2; ++kt)
#pragma unroll
                        for (int r = 0; r < 16; ++r) sa[kt][r] = sa[kt][r] * C1 + c0l;
                } else {
#pragma unroll
                    for (int kt = 0; kt < 2; ++kt) { const int base = qt * 32 + l31 + 128 - (w - LEFT) * CHUNK - kt * 32 - 8 * hh;
#pragma unroll
                        for (int r = 0; r < 16; ++r) sa[kt][r] = sa[kt][r] * C1 + tabh[base - (16 * (r >> 3) + (r & 7))]; }
                }
                float cm = fmaxf(sa[0][0], sa[1][0]);
#pragma unroll
                for (int r = 1; r < 16; ++r) cm = fmaxf(cm, fmaxf(sa[0][r], sa[1][r]));
                cm = fmaxf(cm, __shfl_xor(cm, 32));
                const float mn = fmaxf(m_run[qt], cm);
                const float alpha = __builtin_amdgcn_exp2f(m_run[qt] - mn);
                m_run[qt] = mn;
                float ps = 0.f;
#pragma unroll
                for (int kt = 0; kt < 2; ++kt) {
#pragma unroll
                    for (int r = 0; r < 16; ++r) { const float p = __builtin_amdgcn_exp2f(sa[kt][r] - mn); sa[kt][r] = p; ps += p; }
#pragma unroll
                    for (int s2 = 0; s2 < 2; ++s2) { u32x4 t4; t4.x = cvtpk_s(sa[kt][8 * s2 + 0], sa[kt][8 * s2 + 1]); t4.y = cvtpk_s(sa[kt][8 * s2 + 2], sa[kt][8 * s2 + 3]);
                        t4.z = cvtpk_s(sa[kt][8 * s2 + 4], sa[kt][8 * s2 + 5]); t4.w = cvtpk_s(sa[kt][8 * s2 + 6], sa[kt][8 * s2 + 7]); pw[qt][kt][s2] = t4; }
                }
                l_run[qt] = l_run[qt] * alpha + ps;
#pragma unroll
                for (int dt = 0; dt < 2; ++dt)
#pragma unroll
                    for (int r = 0; r < 16; ++r) o[dt][qt][r] *= alpha;
            }
            const bf16_t* vp = vt + (size_t)(h * HD + l31) * M + key0 + 8 * hh;
#pragma unroll
            for (int kt = 0; kt < 2; ++kt)
#pragma unroll
                for (int s2 = 0; s2 < 2; ++s2) {
                    bf16x8 vf[2];
#pragma unroll
                    for (int dt = 0; dt < 2; ++dt) vf[dt] = *(const bf16x8*)(vp + (size_t)(dt * 32) * M + kt * 32 + 16 * s2);
#pragma unroll
                    for (int qt = 0; qt < 2; ++qt) {
                        const bf16x8 pb = __builtin_bit_cast(bf16x8, pw[qt][kt][s2]);
#pragma unroll
                        for (int dt = 0; dt < 2; ++dt) o[dt][qt] = __builtin_amdgcn_mfma_f32_32x32x16_bf16(vf[dt], pb, o[dt][qt], 0, 0, 0);
                    }
                }
        }
#pragma unroll
        for (int qt = 0; qt < 2; ++qt) {
            const float lt = l_run[qt] + __shfl_xor(l_run[qt], 32);
            const float inv = 1.0f / lt;
            const size_t tok = tok0 + qt * 32 + l31;
            const bf16_t* gp = z + tok * ZP + oag + h * HD + 4 * hh;
            bf16_t* op = og + tok * DA + h * HD + 4 * hh;
#pragma unroll
            for (int dt = 0; dt < 2; ++dt)
#pragma unroll
                for (int g4 = 0; g4 < 4; ++g4) {
                    const uint2 gg = *(const uint2*)(gp + dt * 32 + 8 * g4);
                    const float v0 = o[dt][qt][4 * g4 + 0] * inv * siluf_(bflo(gg.x)), v1 = o[dt][qt][4 * g4 + 1] * inv * siluf_(bfhi(gg.x));
                    const float v2 = o[dt][qt][4 * g4 + 2] * inv * siluf_(bflo(gg.y)), v3 = o[dt][qt][4 * g4 + 3] * inv * siluf_(bfhi(gg.y));
                    uint2 ov; ov.x = cvtpk_s(v0, v1); ov.y = cvtpk_s(v2, v3);
                    *(uint2*)(op + dt * 32 + 8 * g4) = ov;
                }
        }
      }
    }
}

__device__ __forceinline__ void p_ln(float* __restrict__ out, const float* __restrict__ g, const float* __restrict__ bta) {
  const int tid_ = opaque_tid();
  for (int row = blockIdx.x * 8 + (tid_ >> 6); row < M; row += gridDim.x * 8) {
    const int lane = tid_ & 63;
    f32x4* p = (f32x4*)(out + (size_t)row * DM) + lane;
    f32x4 v[4]; float s = 0.f;
#pragma unroll
    for (int j = 0; j < 4; ++j) { v[j] = p[64 * j]; s += (v[j].x + v[j].y) + (v[j].z + v[j].w); }
#pragma unroll
    for (int o = 1; o < 64; o <<= 1) s += __shfl_xor(s, o);
    const float mean = s * (1.0f / DM); float s2 = 0.f;
#pragma unroll
    for (int j = 0; j < 4; ++j) { v[j] = v[j] - mean; s2 += (v[j].x * v[j].x + v[j].y * v[j].y) + (v[j].z * v[j].z + v[j].w * v[j].w); }
#pragma unroll
    for (int o = 1; o < 64; o <<= 1) s2 += __shfl_xor(s2, o);
    const float rstd = 1.0f / sqrtf(s2 * (1.0f / DM) + LN_EPS);
#pragma unroll
    for (int j = 0; j < 4; ++j) { const f32x4 gg = ((const f32x4*)g)[lane + 64 * j], bb = ((const f32x4*)bta)[lane + 64 * j]; p[64 * j] = v[j] * rstd * gg + bb; }
  }
}

constexpr int LDS_BYTES = 147456;
struct Params { const float* in[14]; float* out; unsigned char* ws; };
__global__ void __launch_bounds__(512, 2) fwd_megakernel(Params p) {
    cg::grid_group grid = cg::this_grid();
    extern __shared__ __attribute__((aligned(16))) unsigned char lds[];
    PG8_LAS unsigned char* ldsp = (PG8_LAS unsigned char*)lds;
    const float* x = p.in[0]; const float* w_in = p.in[1]; const float* b_in = p.in[2];
    const float* conv_w = p.in[3]; const float* conv_b = p.in[4]; const float* cln_g = p.in[5]; const float* cln_b = p.in[6];
    const float* w_co = p.in[7]; const float* relb = p.in[8]; const float* w_ao = p.in[9];
    const float* w_o = p.in[10]; const float* b_o = p.in[11]; const float* oln_g = p.in[12]; const float* oln_b = p.in[13];
    unsigned char* ws = p.ws; float* out = p.out;
    bf16_t* Win_t = (bf16_t*)(ws + WS_WIN); bf16_t* Wc_t = (bf16_t*)(ws + WS_WC); bf16_t* Wa_t = (bf16_t*)(ws + WS_WA); bf16_t* Wo_t = (bf16_t*)(ws + WS_WO);
    bf16_t* xb = (bf16_t*)(ws + WS_XB); bf16_t* hb = (bf16_t*)(ws + WS_H); bf16_t* z = (bf16_t*)(ws + WS_Z); bf16_t* uc = (bf16_t*)(ws + WS_UC); bf16_t* og = (bf16_t*)(ws + WS_OG); bf16_t* ub = (bf16_t*)(ws + WS_U); bf16_t* vt = (bf16_t*)(ws + WS_VT);
    const int G = (int)gridDim.x, bid = (int)blockIdx.x;
    const int vcu = (G % 8 == 0) ? (bid % 8) * (G / 8) + bid / 8 : bid;
    p_cvt(x, xb, (size_t)M * DM / 8);
    p_weights(w_in, w_co, w_ao, w_o, Win_t, Wc_t, Wa_t, Wo_t, ldsp, vcu * 8 + (int)(threadIdx.x >> 6), G * 8);
    grid.sync();
    { pg8::Gemm g{xb, Win_t, M, N1, DM}; pg8::StaticOrder S; S.init(M, N1, G, bid);
      pg8::EpiZ2 E{z, ub, b_in};
      pg8::gemm_phase<pg8::EpiZ2, pg8::StaticOrder, PG8_ALIGN, PG8_SP2>(ldsp, g, S, E); }
    { pg8::Gemm g{Win_t + (size_t)N1 * DM, xb, DA, M, DM}; pg8::StaticOrder S; S.init(DA, M, G, bid);
      pg8::EpiVT E{vt, M, b_in + O_V};
      pg8::gemm_phase<pg8::EpiVT, pg8::StaticOrder, PG8_ALIGN, PG8_SP2>(ldsp, g, S, E); }
    grid.sync();
    p_conv(ub, z, conv_w, conv_b, cln_g, cln_b, uc, ldsp, vcu, G);
    p_attn<ZP>(z, Z_Q, Z_K, Z_AG, vt, relb, og, (PG8_LAS float*)ldsp, vcu, G);
    grid.sync();
    { pg8::Gemm g{uc, Wc_t, M, DM, DC, og, Wa_t}; pg8::StaticOrder2 S; S.init(M, DM, G, bid);
      pg8::EpiMerge E{z, hb};
      pg8::gemm_phase<pg8::EpiMerge, pg8::StaticOrder2, PG8_ALIGN, PG8_SP2>(ldsp, g, S, E); }
    grid.sync();
    { pg8::Gemm g{hb, Wo_t, M, DM, DM}; pg8::StaticOrder S; S.init(M, DM, G, bid);
      pg8::EpiRes E{out, x, b_o};
      pg8::gemm_phase<pg8::EpiRes, pg8::StaticOrder, PG8_ALIGN, PG8_SP2>(ldsp, g, S, E); }
    grid.sync();
    p_ln(out, oln_g, oln_b);
}

extern "C" void kernel_launch(void* const* d_in, const int* in_sizes, int n_in, void* d_out, int out_size, void* d_ws, size_t ws_size, hipStream_t stream) {
    if (n_in != 14 || in_sizes[0] != M * DM || out_size != M * DM || ws_size < WS_END) { fprintf(stderr, "kernel_launch: unexpected shapes / workspace (n_in %d, ws %zu)\n", n_in, ws_size); return; }
    static int grid_blocks = 0;
    if (!grid_blocks) {
        int dev = 0, cus = 0, per_cu = 0;
        (void)hipGetDevice(&dev);
        (void)hipDeviceGetAttribute(&cus, hipDeviceAttributeMultiprocessorCount, dev);
        if (hipFuncSetAttribute((const void*)fwd_megakernel, hipFuncAttributeMaxDynamicSharedMemorySize, LDS_BYTES) != hipSuccess) fprintf(stderr, "kernel_launch: hipFuncSetAttribute failed\n");
        (void)hipOccupancyMaxActiveBlocksPerMultiprocessor(&per_cu, fwd_megakernel, 512, LDS_BYTES);
        if (per_cu < 1) { fprintf(stderr, "kernel_launch: occupancy query returned %d\n", per_cu); }
        grid_blocks = cus;
    }
    Params p{};
    for (int i = 0; i < 14; ++i) p.in[i] = (const float*)d_in[i];
    p.out = (float*)d_out; p.ws = (unsigned char*)d_ws;
    void* args[] = {&p};
    hipError_t e = hipLaunchCooperativeKernel((void*)fwd_megakernel, dim3(grid_blocks), dim3(512), args, LDS_BYTES, stream);
    if (e != hipSuccess) fprintf(stderr, "cooperative launch failed: %s (grid %d)\n", hipGetErrorString(e), grid_blocks);
}
```
